# Optimizing an MI355X kernel written in HIP

```python
import math
import jax, jax.numpy as jnp
from jax import lax
import numpy as np


D_MODEL = 1024
BATCH = 2
SEQ = 16384
DEPTH = 4

N_A_LAYERS = DEPTH // 2
N_B_LAYERS = DEPTH - N_A_LAYERS
D_FF = 4 * D_MODEL
NORM_EPS = 1e-6

M_HEADS = 4
M_V_DIM = D_MODEL // M_HEADS
M_QK_DIM = M_V_DIM // 2
M_CHUNK = 64
GATE_SOFTCAP = 15.0
M_QK_COLS = M_HEADS * M_QK_DIM
M_PROJ = 2 * M_QK_COLS + 2 * D_MODEL + 2 * M_HEADS

A_HEADS = 8
A_HEAD_DIM = D_MODEL // (2 * A_HEADS)
A_V_DIM = 2 * A_HEAD_DIM
Q_BLOCK = 128
ROPE_THETA = 10000.0

kernel_name = 'yoco_mlstm_diffattn_hybrid'


def rmsnorm(x, g):
    xf = x.astype(jnp.float32)
    y = xf * lax.rsqrt(jnp.mean(xf * xf, axis=-1, keepdims=True) + NORM_EPS)
    return (y * g.astype(jnp.float32)).astype(x.dtype)


def softcap(x, cap):
    return cap * jnp.tanh(x / cap)


def rope_tables(positions, dim):
    inv = 1.0 / (ROPE_THETA ** (jnp.arange(0, dim, 2, dtype=jnp.float32) / dim))
    ang = positions.astype(jnp.float32)[..., None] * inv
    return jnp.cos(ang), jnp.sin(ang)


def apply_rope(t, cos, sin):
    t1, t2 = jnp.split(t.astype(jnp.float32), 2, axis=-1)
    c = cos[:, :, None, :]
    s = sin[:, :, None, :]
    return jnp.concatenate([t1 * c - t2 * s, t2 * c + t1 * s], axis=-1).astype(t.dtype)


def sqrelu_mlp(h, w_up, w_down):
    u = jax.nn.relu(h @ w_up)
    return (u * u) @ w_down


def mlstm_mixer(h, w_in, b_gates, g_head, w_out):
    B, S, _ = h.shape
    L = M_CHUNK
    nc = S // L
    proj = h @ w_in
    cuts = [M_QK_COLS, 2 * M_QK_COLS, 2 * M_QK_COLS + D_MODEL, 2 * M_QK_COLS + 2 * D_MODEL]
    q, k, v, o, gts = jnp.split(proj, cuts, axis=-1)
    gts = softcap((gts + b_gates).astype(jnp.float32), GATE_SOFTCAP)
    log_i = gts[..., :M_HEADS]
    log_f = jax.nn.log_sigmoid(gts[..., M_HEADS:])

    def to_chunks(t, dh):
        return t.astype(jnp.float32).reshape(B, nc, L, M_HEADS, dh).transpose(1, 0, 3, 2, 4)

    def gate_chunks(t):
        return t.reshape(B, nc, L, M_HEADS).transpose(1, 0, 3, 2)

    qc = to_chunks(q, M_QK_DIM)
    kc = to_chunks(k, M_QK_DIM) * (M_QK_DIM ** -0.5)
    vc = to_chunks(v, M_V_DIM)
    ic = gate_chunks(log_i)
    fc = gate_chunks(log_f)
    causal = jnp.tril(jnp.ones((L, L), dtype=bool))

    def step(carry, xs):
        C, n, m = carry
        q_, k_, v_, li, lf = xs
        b = jnp.cumsum(lf, axis=-1)
        dmat = b[..., :, None] - b[..., None, :] + li[..., None, :]
        dmat = jnp.where(causal, dmat, -jnp.inf)
        inter = b + m[..., None]
        m_row = jnp.maximum(inter, jnp.max(dmat, axis=-1))
        w_intra = jnp.exp(dmat - m_row[..., None])
        s_inter = jnp.exp(inter - m_row)
        s_qk = jnp.einsum('bhjd,bhsd->bhjs', q_, k_) * w_intra
        num = (s_inter[..., None] * jnp.einsum('bhjd,bhde->bhje', q_, C)
               + jnp.einsum('bhjs,bhse->bhje', s_qk, v_))
        den = s_inter * jnp.einsum('bhjd,bhd->bhj', q_, n) + jnp.sum(s_qk, axis=-1)
        h_out = num / jnp.maximum(jnp.abs(den), jnp.exp(-m_row))[..., None]
        b_last = b[..., -1]
        g_s = b_last[..., None] - b + li
        m_new = jnp.maximum(b_last + m, jnp.max(g_s, axis=-1))
        decay = jnp.exp(b_last + m - m_new)
        w_s = jnp.exp(g_s - m_new[..., None])
        C_new = decay[..., None, None] * C + jnp.einsum('bhs,bhsd,bhse->bhde', w_s, k_, v_)
        n_new = decay[..., None] * n + jnp.einsum('bhs,bhsd->bhd', w_s, k_)
        return (C_new, n_new, m_new), h_out

    init = (jnp.zeros((B, M_HEADS, M_QK_DIM, M_V_DIM), jnp.float32),
            jnp.zeros((B, M_HEADS, M_QK_DIM), jnp.float32),
            jnp.zeros((B, M_HEADS), jnp.float32))
    _, hs = lax.scan(step, init, (qc, kc, vc, ic, fc))
    hs = hs.transpose(1, 0, 3, 2, 4).reshape(B, S, M_HEADS, M_V_DIM)
    hs = rmsnorm(hs, g_head.reshape(M_HEADS, M_V_DIM))
    og = jax.nn.sigmoid(o.astype(jnp.float32)).reshape(B, S, M_HEADS, M_V_DIM)
    y = (og * hs).reshape(B, S, D_MODEL).astype(h.dtype)
    return y @ w_out


def shared_kv(x, kv_norm_g, w_kv, cos, sin):
    B, S, _ = x.shape
    kv = rmsnorm(x, kv_norm_g) @ w_kv
    k = kv[..., :D_MODEL].reshape(B, S, 2 * A_HEADS, A_HEAD_DIM)
    k = apply_rope(k, cos, sin).reshape(B, S, A_HEADS, 2, A_HEAD_DIM)
    v = kv[..., D_MODEL:].reshape(B, S, A_HEADS, A_V_DIM)
    return k, v


def diff_attention(h, w_q, lam, g_head, w_out, k_sh, v_sh, cos, sin, lam_init):
    B, S, _ = h.shape
    nb = S // Q_BLOCK
    q = (h @ w_q).reshape(B, S, 2 * A_HEADS, A_HEAD_DIM)
    q = apply_rope(q, cos, sin) * (A_HEAD_DIM ** -0.5)
    q = q.reshape(B, nb, Q_BLOCK, A_HEADS, 2, A_HEAD_DIM).transpose(1, 0, 2, 3, 4, 5)
    lamf = lam.astype(jnp.float32)
    lam_full = (jnp.exp(jnp.sum(lamf[0] * lamf[1])) - jnp.exp(jnp.sum(lamf[2] * lamf[3]))
                + lam_init)
    k_idx = jnp.arange(S)

    def block(args):
        qi, bi = args
        scores = jnp.einsum('bqhcd,bkhcd->bhcqk', qi, k_sh).astype(jnp.float32)
        q_idx = bi * Q_BLOCK + jnp.arange(Q_BLOCK)
        mask = k_idx[None, :] <= q_idx[:, None]
        scores = jnp.where(mask, scores, -jnp.inf)
        p = jax.nn.softmax(scores, axis=-1)
        pd = p[:, :, 0] - lam_full * p[:, :, 1]
        return jnp.einsum('bhqk,bkhe->bqhe', pd.astype(v_sh.dtype), v_sh)

    o = lax.map(block, (q, jnp.arange(nb)))
    o = o.transpose(1, 0, 2, 3, 4).reshape(B, S, A_HEADS, A_V_DIM)
    o = rmsnorm(o, g_head.reshape(A_HEADS, A_V_DIM)) * (1.0 - lam_init)
    return o.reshape(B, S, D_MODEL) @ w_out


def setup_inputs(seed: int = 0) -> dict:
    key = jax.random.key(seed)
    ks = jax.random.split(key, 16)
    f32 = jnp.float32
    nrm = jax.random.normal
    x = nrm(ks[0], (BATCH, SEQ, D_MODEL), f32)
    positions = jnp.broadcast_to(jnp.arange(SEQ, dtype=jnp.int32)[None, :], (BATCH, SEQ))
    norm_g = 1.0 + 0.02 * nrm(ks[1], (DEPTH, 4, D_MODEL), f32)
    a_w_in = nrm(ks[2], (N_A_LAYERS, D_MODEL, M_PROJ), f32) * D_MODEL ** -0.5
    ig_b = 0.1 * nrm(ks[3], (N_A_LAYERS, M_HEADS), f32)
    fg_b = jnp.linspace(3.0, 6.0, M_HEADS, dtype=f32)[None, :] + 0.1 * nrm(ks[4], (N_A_LAYERS, M_HEADS), f32)
    a_b_gates = jnp.concatenate([ig_b, fg_b], axis=-1)
    a_g_head = 1.0 + 0.02 * nrm(ks[5], (N_A_LAYERS, D_MODEL), f32)
    a_w_out = nrm(ks[6], (N_A_LAYERS, D_MODEL, D_MODEL), f32) * D_MODEL ** -0.5
    kv_norm_g = 1.0 + 0.02 * nrm(ks[7], (D_MODEL,), f32)
    w_kv = nrm(ks[8], (D_MODEL, 2 * D_MODEL), f32) * D_MODEL ** -0.5
    b_w_q = nrm(ks[9], (N_B_LAYERS, D_MODEL, D_MODEL), f32) * D_MODEL ** -0.5
    b_lam = 0.1 * nrm(ks[10], (N_B_LAYERS, 4, A_HEAD_DIM), f32)
    b_g_head = 1.0 + 0.02 * nrm(ks[11], (N_B_LAYERS, D_MODEL), f32)
    b_w_out = nrm(ks[12], (N_B_LAYERS, D_MODEL, D_MODEL), f32) * D_MODEL ** -0.5
    mlp_w_up = nrm(ks[13], (DEPTH, D_MODEL, D_FF), f32) * D_MODEL ** -0.5
    mlp_w_down = nrm(ks[14], (DEPTH, D_FF, D_MODEL), f32) * D_FF ** -0.5
    return {'x': x, 'positions': positions, 'norm_g': norm_g,
            'a_w_in': a_w_in, 'a_b_gates': a_b_gates, 'a_g_head': a_g_head, 'a_w_out': a_w_out,
            'kv_norm_g': kv_norm_g, 'w_kv': w_kv,
            'b_w_q': b_w_q, 'b_lam': b_lam, 'b_g_head': b_g_head, 'b_w_out': b_w_out,
            'mlp_w_up': mlp_w_up, 'mlp_w_down': mlp_w_down}


def reference(x, positions, norm_g, a_w_in, a_b_gates, a_g_head, a_w_out,
              kv_norm_g, w_kv, b_w_q, b_lam, b_g_head, b_w_out, mlp_w_up, mlp_w_down):
    cos, sin = rope_tables(positions, A_HEAD_DIM)
    k_sh = None
    v_sh = None
    for layer in range(DEPTH):
        g = norm_g[layer]
        if layer < N_A_LAYERS:
            y = mlstm_mixer(rmsnorm(x, g[0]), a_w_in[layer], a_b_gates[layer],
                            a_g_head[layer], a_w_out[layer])
        else:
            j = layer - N_A_LAYERS
            if j == 0:
                k_sh, v_sh = shared_kv(x, kv_norm_g, w_kv, cos, sin)
            lam_init = 0.8 - 0.6 * math.exp(-0.3 * layer)
            y = diff_attention(rmsnorm(x, g[0]), b_w_q[j], b_lam[j], b_g_head[j], b_w_out[j],
                               k_sh, v_sh, cos, sin, lam_init)
        x = x + rmsnorm(y, g[1])
        x = x + rmsnorm(sqrelu_mlp(rmsnorm(x, g[2]), mlp_w_up[layer], mlp_w_down[layer]), g[3])
    return x
```

```cpp
#include <hip/hip_runtime.h>
#include <hip/hip_cooperative_groups.h>
#include <cstdio>
#include <cstdint>
#include <cmath>
namespace pg8 {
#define PG8_LAS __attribute__((address_space(3)))
typedef unsigned short bf16_t;
typedef short bf16x8 __attribute__((ext_vector_type(8)));
typedef float f32x4 __attribute__((ext_vector_type(4)));
typedef unsigned u32x4 __attribute__((ext_vector_type(4)));
constexpr int BM = 256, BK = 64, HALF = 128, HTB = HALF * BK * 2  , STAGE_BYTES = 8 * HTB, NXCD = 8, WGM = 8;

__host__ __device__ __forceinline__ int lds_byte(int r, int c) { const int st = (r >> 4) * 2 + (c >> 5), rr = r & 15, cc = c & 31, ob = rr * 64 + cc * 2; return st * 1024 + (ob ^ (((ob >> 9) & 1) << 5)); }
__host__ __device__ __forceinline__ void stage_rc(int b, int& R, int& C) { const int st = b / 1024, sb = b % 1024, swz = sb ^ (((sb >> 9) & 1) << 5); R = (st >> 1) * 16 + swz / 64; C = (st & 1) * 32 + (swz % 64) / 2; }
__host__ __device__ __forceinline__ int perm32(int rho) { const int n = rho >> 4, i = rho & 15; return 8 * (i >> 2) + 4 * n + (i & 3); }

struct Unit { int pm, pn; };
struct Gemm { const bf16_t* A; const bf16_t* Bt; int M, N, K; };

struct StaticOrder {
    int nM, nN, nwg, G, c;
    __host__ __device__ void init(int M, int N, int G_, int c_) { nM = M / BM; nN = N / BM; nwg = nM * nN; G = G_; c = c_; }
    __host__ __device__ bool next(int i, Unit& u) const {
        const long L = (long)i * G + c; if (L >= nwg) return false;
        int wgid = (int)L; { const int q = nwg / NXCD, r = nwg % NXCD, xcd = wgid % NXCD, off = wgid / NXCD; wgid = (xcd < r ? xcd * (q + 1) : r * (q + 1) + (xcd - r) * q) + off; }
        const int nig = WGM * nN, gid = wgid / nig, fm = gid * WGM, gsz = (nM - fm) < WGM ? (nM - fm) : WGM;
        u.pm = fm + ((wgid % nig) % gsz); u.pn = (wgid % nig) / gsz; return true;
    }
    __device__ __forceinline__ void a_ready(const Unit&) const {}
    __device__ __forceinline__ void done(const Unit&) const {}
};

__device__ __forceinline__ unsigned cvt_pk_bf16(float lo, float hi) { unsigned r; asm volatile("v_cvt_pk_bf16_f32 %0, %1, %2" : "=v"(r) : "v"(lo), "v"(hi)); return r; }
typedef float f32x2 __attribute__((ext_vector_type(2)));
struct EpiBf16 {
    static constexpr bool PERM = true, AFTER_DRAIN = false;
    bf16_t* O; int ldc; int act; int split_cols; size_t split_stride; float scale0; const float* rope; int rope_cols;
    __device__ __forceinline__ void operator()(const f32x4 (&acc)[2][2][4][2], const Unit& u, int wr, int wc, int fr, int fq) const {
        const int row0 = u.pm * BM + wr * 64 + fr; int colt = u.pn * BM; bf16_t* base = O;
        float sc = 1.f; if (split_cols) { const int t = colt / split_cols; base += (size_t)t * split_stride; colt -= t * split_cols; if (t == 0) sc = scale0; }
        const int col0 = colt + wc * 32 + 8 * fq;
        if (rope != nullptr && u.pn * BM < rope_cols) {
            typedef unsigned u32x2 __attribute__((ext_vector_type(2)));
#pragma unroll
            for (int ai = 0; ai < 2; ++ai)
#pragma unroll
                for (int m = 0; m < 4; ++m) { const size_t row = (size_t)(row0 + ai * HALF + m * 16);
#pragma unroll
                    for (int bj = 0; bj < 2; ++bj) { const int gc = col0 + bj * HALF, hd6 = gc & ~63, m4 = ((gc & 63) >> 3) * 4;
                        const float* tp = rope + row * 64 + m4; const f32x4 cs = *(const f32x4*)tp, sn = *(const f32x4*)(tp + 32);
                        const f32x4 v0 = acc[ai][bj][m][0], v1 = acc[ai][bj][m][1];
                        const f32x4 o1 = (v0 * cs - v1 * sn) * sc, o2 = (v1 * cs + v0 * sn) * sc;
                        u32x2 w1, w2; w1.x = cvt_pk_bf16(o1[0], o1[1]); w1.y = cvt_pk_bf16(o1[2], o1[3]); w2.x = cvt_pk_bf16(o2[0], o2[1]); w2.y = cvt_pk_bf16(o2[2], o2[3]);
                        bf16_t* rp = base + row * ldc + hd6 + m4; *(u32x2*)rp = w1; *(u32x2*)(rp + 32) = w2; } }
            return;
        }
#pragma unroll
        for (int ai = 0; ai < 2; ++ai)
#pragma unroll
            for (int m = 0; m < 4; ++m) { bf16_t* rowp = base + (size_t)(row0 + ai * HALF + m * 16) * ldc + col0;
#pragma unroll
                for (int bj = 0; bj < 2; ++bj) { f32x4 v0 = acc[ai][bj][m][0], v1 = acc[ai][bj][m][1];
                    if (act == 2) {
#pragma unroll
                        for (int e = 0; e < 4; ++e) { const float a0 = fmaxf(v0[e], 0.f), a1 = fmaxf(v1[e], 0.f); v0[e] = a0 * a0; v1[e] = a1 * a1; } }
                    v0 = v0 * sc; v1 = v1 * sc; u32x4 w; w.x = cvt_pk_bf16(v0[0], v0[1]); w.y = cvt_pk_bf16(v0[2], v0[3]); w.z = cvt_pk_bf16(v1[0], v1[1]); w.w = cvt_pk_bf16(v1[2], v1[3]);
                    *(u32x4*)(rowp + bj * HALF) = w; } }
    }
};

template <class Epi, class Sched, bool ALIGN_EPI = false, bool SP2 = false>
__device__ __forceinline__ void gemm_phase(PG8_LAS unsigned char* lds, const Gemm g, const Sched& S, const Epi& E) {
    int tid_o = threadIdx.x; asm volatile("" : "+v"(tid_o));
    const int tid = tid_o, wid = __builtin_amdgcn_readfirstlane(tid >> 6), lane = tid & 63, wr = wid >> 2, wc = wid & 3, fr = lane & 15, fq = lane >> 4;
    const int K = g.K, nt = K / BK;
    unsigned voffA[2], voffB[2];
#pragma unroll
    for (int i = 0; i < 2; ++i) { int R, C; stage_rc(tid * 16 + i * 8192, R, C); const int Rb = Epi::PERM ? ((R & ~31) + perm32(R & 31)) : R;
        voffA[i] = (unsigned)(R * K + C) * 2u; voffB[i] = (unsigned)(Rb * K + C) * 2u; }
    const size_t kstep = (size_t)(BK * 2);
    const size_t hstep = (size_t)HALF * K * 2;
    const size_t tstep = 2 * hstep;
    const unsigned ldsw = (unsigned)wid * 1024u;
    const int aoff = lds_byte(wr * 64 + fr, fq * 8), boff = lds_byte(wc * 32 + fr, fq * 8);
#define PG8_SA(b, h) (((b) * 2 + (h)) * HTB)
#define PG8_SB(b, h) ((4 + (b) * 2 + (h)) * HTB)
#define PG8_STAGE(bufoff, gbase, voff) do { _Pragma("unroll") for (int _i = 0; _i < 2; ++_i) \
        __builtin_amdgcn_global_load_lds((const unsigned*)((const char*)(gbase) + (voff)[_i]), (PG8_LAS unsigned*)(lds + (bufoff) + ldsw + _i * 8192), 16, 0, 0); } while (0)
#define PG8_LDA(dst, b, h) do { _Pragma("unroll") for (int m = 0; m < 4; ++m) _Pragma("unroll") for (int k = 0; k < 2; ++k) dst[m][k] = *(const PG8_LAS bf16x8*)(lds + PG8_SA(b, h) + aoff + m * 2048 + k * 1024); } while (0)
#define PG8_LDB(dst, b, h) do { _Pragma("unroll") for (int n = 0; n < 2; ++n) _Pragma("unroll") for (int k = 0; k < 2; ++k) dst[n][k] = *(const PG8_LAS bf16x8*)(lds + PG8_SB(b, h) + boff + n * 2048 + k * 1024); } while (0)
#define PG8_MMA(ai, bj, At, Bt) do { __builtin_amdgcn_s_setprio(1); _Pragma("unroll") for (int m = 0; m < 4; ++m) _Pragma("unroll") for (int n = 0; n < 2; ++n) _Pragma("unroll") for (int k = 0; k < 2; ++k) \
        acc[ai][bj][m][n] = __builtin_amdgcn_mfma_f32_16x16x32_bf16(Bt[n][k], At[m][k], acc[ai][bj][m][n], 0, 0, 0); __builtin_amdgcn_s_setprio(0); } while (0)
#define PG8_WAIT_V(n) asm volatile("s_waitcnt vmcnt(" #n ")" ::: "memory")
#define PG8_WAIT_L(n) asm volatile("s_waitcnt lgkmcnt(" #n ")" ::: "memory")
#define PG8_BAR __builtin_amdgcn_s_barrier()
#define PG8_SCHED __builtin_amdgcn_sched_barrier(0)
    Unit cur, nxt; int ui = 0;
    if (!S.next(0, cur)) return;
    f32x4 acc[2][2][4][2];
#pragma unroll
    for (int a = 0; a < 2; ++a)
#pragma unroll
        for (int b = 0; b < 2; ++b)
#pragma unroll
            for (int m = 0; m < 4; ++m)
#pragma unroll
                for (int n = 0; n < 2; ++n) acc[a][b][m][n] = (f32x4){0.f, 0.f, 0.f, 0.f};
    bf16x8 At[4][2], B0[2][2], B1[2][2];
    const char* cA = (const char*)g.A + (size_t)cur.pm * tstep; const char* cB = (const char*)g.Bt + (size_t)cur.pn * tstep;
    S.a_ready(cur);
    if constexpr (SP2) {
        PG8_STAGE(PG8_SB(0, 0), cB, voffB); PG8_STAGE(PG8_SB(0, 1), cB + hstep, voffB); PG8_STAGE(PG8_SA(0, 0), cA, voffA); PG8_STAGE(PG8_SA(0, 1), cA + hstep, voffA);
        if (wr == 1) PG8_BAR;
        PG8_WAIT_V(2); PG8_BAR;
        PG8_STAGE(PG8_SB(1, 0), cB + kstep, voffB); PG8_STAGE(PG8_SA(1, 0), cA + kstep, voffA); PG8_STAGE(PG8_SB(1, 1), cB + hstep + kstep, voffB);
        PG8_WAIT_V(6); PG8_BAR;
    } else {
        PG8_STAGE(PG8_SB(0, 0), cB, voffB); PG8_STAGE(PG8_SA(0, 0), cA, voffA); PG8_STAGE(PG8_SB(0, 1), cB + hstep, voffB); PG8_STAGE(PG8_SA(0, 1), cA + hstep, voffA);
        if (wr == 1) PG8_BAR;
        PG8_WAIT_V(4); PG8_BAR;
        PG8_STAGE(PG8_SB(1, 0), cB + kstep, voffB); PG8_STAGE(PG8_SA(1, 0), cA + kstep, voffA); PG8_STAGE(PG8_SB(1, 1), cB + hstep + kstep, voffB);
        PG8_WAIT_V(6); PG8_BAR;
    }
    for (;;) {
        const bool has_next = S.next(ui + 1, nxt);
        const char* nA = has_next ? (const char*)g.A + (size_t)nxt.pm * tstep : cA; const char* nB = has_next ? (const char*)g.Bt + (size_t)nxt.pn * tstep : cB;
        for (int t = 0; t < nt; t += 2) {
            const bool last = (t == nt - 2);
            const char* a1 = cA + (size_t)(t + 1) * kstep;
            const char* a2 = last ? nA : cA + (size_t)(t + 2) * kstep; const char* b2 = last ? nB : cB + (size_t)(t + 2) * kstep;
            const char* a3 = a2 + kstep; const char* b3 = b2 + kstep;
            if (last && has_next) S.a_ready(nxt);
            if constexpr (SP2) {
            PG8_LDB(B0, 0, 0); PG8_LDB(B1, 0, 1); PG8_SCHED; PG8_LDA(At, 0, 0); PG8_STAGE(PG8_SA(1, 1), a1 + hstep, voffA);
            PG8_WAIT_V(8); PG8_WAIT_L(0); PG8_BAR; PG8_MMA(0, 0, At, B0); PG8_MMA(0, 1, At, B1); PG8_BAR; PG8_SCHED;
            PG8_LDA(At, 0, 1); PG8_STAGE(PG8_SB(0, 0), b2, voffB); PG8_STAGE(PG8_SB(0, 1), b2 + hstep, voffB); PG8_STAGE(PG8_SA(0, 0), a2, voffA);
            PG8_WAIT_V(8); PG8_WAIT_L(0); PG8_BAR; PG8_MMA(1, 0, At, B0); PG8_MMA(1, 1, At, B1); PG8_BAR; PG8_SCHED;
            PG8_LDB(B0, 1, 0); PG8_LDB(B1, 1, 1); PG8_SCHED; PG8_LDA(At, 1, 0); PG8_STAGE(PG8_SA(0, 1), a2 + hstep, voffA);
            PG8_WAIT_V(8); PG8_WAIT_L(0); PG8_BAR; PG8_MMA(0, 0, At, B0); PG8_MMA(0, 1, At, B1); PG8_BAR; PG8_SCHED;
            PG8_LDA(At, 1, 1); PG8_STAGE(PG8_SB(1, 0), b3, voffB); PG8_STAGE(PG8_SB(1, 1), b3 + hstep, voffB); PG8_STAGE(PG8_SA(1, 0), a3, voffA);
            PG8_WAIT_V(8); PG8_WAIT_L(0); PG8_BAR; PG8_MMA(1, 0, At, B0); PG8_MMA(1, 1, At, B1); PG8_BAR; PG8_SCHED;
            } else {
            PG8_LDB(B0, 0, 0); PG8_SCHED; PG8_LDA(At, 0, 0); PG8_STAGE(PG8_SA(1, 1), a1 + hstep, voffA);
            PG8_WAIT_L(8); PG8_BAR; PG8_WAIT_L(0); PG8_MMA(0, 0, At, B0); PG8_BAR; PG8_SCHED;
            PG8_LDB(B1, 0, 1); PG8_STAGE(PG8_SB(0, 0), b2, voffB);
            PG8_BAR; PG8_WAIT_L(0); PG8_MMA(0, 1, At, B1); PG8_BAR;
            PG8_LDA(At, 0, 1); PG8_STAGE(PG8_SA(0, 0), a2, voffA);
            PG8_BAR; PG8_WAIT_L(0); PG8_MMA(1, 0, At, B0); PG8_BAR; PG8_SCHED;
            PG8_STAGE(PG8_SB(0, 1), b2 + hstep, voffB);
            PG8_WAIT_V(6); PG8_BAR; PG8_MMA(1, 1, At, B1); PG8_BAR;
            PG8_LDB(B0, 1, 0); PG8_SCHED; PG8_LDA(At, 1, 0); PG8_STAGE(PG8_SA(0, 1), a2 + hstep, voffA);
            PG8_WAIT_L(8); PG8_BAR; PG8_WAIT_L(0); PG8_MMA(0, 0, At, B0); PG8_BAR; PG8_SCHED;
            PG8_LDB(B1, 1, 1); PG8_STAGE(PG8_SB(1, 0), b3, voffB);
            PG8_BAR; PG8_WAIT_L(0); PG8_MMA(0, 1, At, B1); PG8_BAR;
            PG8_LDA(At, 1, 1); PG8_STAGE(PG8_SA(1, 0), a3, voffA);
            PG8_BAR; PG8_WAIT_L(0); PG8_MMA(1, 0, At, B0); PG8_BAR; PG8_SCHED;
            PG8_STAGE(PG8_SB(1, 1), b3 + hstep, voffB);
            PG8_WAIT_V(6); PG8_BAR; PG8_MMA(1, 1, At, B1); PG8_BAR;
            }
        }
        if constexpr (ALIGN_EPI) { if (wr == 0) PG8_BAR; }
        if constexpr (!Epi::AFTER_DRAIN) { E(acc, cur, wr, wc, fr, fq); S.done(cur); }
        if (!has_next) break;
#pragma unroll
        for (int a = 0; a < 2; ++a)
#pragma unroll
            for (int b = 0; b < 2; ++b)
#pragma unroll
                for (int m = 0; m < 4; ++m)
#pragma unroll
                    for (int n = 0; n < 2; ++n) acc[a][b][m][n] = (f32x4){0.f, 0.f, 0.f, 0.f};
        cur = nxt; cA = nA; cB = nB; ++ui;
        if constexpr (ALIGN_EPI) { if (wr == 1) PG8_BAR; }
    }
    PG8_WAIT_V(0);
    if constexpr (!ALIGN_EPI) { if (wr == 0) PG8_BAR; }
    PG8_BAR;
    if constexpr (Epi::AFTER_DRAIN) { E.fused(acc, cur, wr, wc, fr, fq, lds, wid, lane); S.done(cur); }
#undef PG8_SA
#undef PG8_SB
#undef PG8_STAGE
#undef PG8_LDA
#undef PG8_LDB
#undef PG8_MMA
#undef PG8_WAIT_V
#undef PG8_WAIT_L
#undef PG8_BAR
#undef PG8_SCHED
}
}

#include <hip/hip_bf16.h>
#include <cmath>
namespace attn_body {
using bf16=__hip_bfloat16;
using bf16x8=__attribute__((ext_vector_type(8)))short;
using s16x4=__attribute__((ext_vector_type(4)))short;
using f32x16=__attribute__((ext_vector_type(16)))float;
using u32x4=__attribute__((ext_vector_type(4)))unsigned;
constexpr int BATCH=2,NHEAD=16,SEQ=16384,D=64,DM=NHEAD*D,OPITCH=2048;
constexpr int NW=8,QBLK=32,QB=QBLK*NW,KVBLK=64,NQB=SEQ/QB;
constexpr int ATTN_PITCH=DM, ATTN_UNIT_ROWS=QB;
__device__ __forceinline__ int crow(int r,int hi){return (r&3)+8*(r>>2)+4*hi;}
#define SBAR() __builtin_amdgcn_sched_barrier(0)
__device__ __forceinline__ void cmask(f32x16&p0,f32x16&p1,int jb,int qrel,int hi){
  const float NEG=-INFINITY; int kb=64*jb+4*hi;
  #pragma unroll
  for(int r=0;r<16;++r){int kv=kb+(r&3)+8*(r>>2); if(kv>qrel)p0[r]=NEG; if(kv+32>qrel)p1[r]=NEG;}
}

constexpr int NSLOT=3, SLOTB=8192;
constexpr int LDS_K=0, LDS_V=NSLOT*SLOTB, LDS_V2=2*NSLOT*SLOTB, LDS_WS=3*NSLOT*SLOTB, LDS_OST=LDS_WS+NW*64*4, LDS_BYTES=LDS_OST+NW*8192;
constexpr float C2=0.125f*1.4426950408889634f;
__device__ __forceinline__ void glds16(const void*gsrc,unsigned lds_dst){unsigned keep;
  asm volatile("s_mov_b32 %0, m0\n\ts_mov_b32 m0, %2\n\ts_nop 0\n\tglobal_load_lds_dwordx4 %1, off\n\ts_mov_b32 m0, %0":"=&s"(keep):"v"(gsrc),"s"(lds_dst):"memory");}
__device__ __forceinline__ float max3f(float a,float b,float c){float r;asm("v_max3_f32 %0, %1, %2, %3":"=v"(r):"v"(a),"v"(b),"v"(c));return r;}
__device__ __forceinline__ float max2f(float a,float b){float r;asm("v_max_f32_e32 %0, %1, %2":"=v"(r):"v"(a),"v"(b));return r;}
__device__ __forceinline__ float fadd_s(float a,float b){float r;asm("v_add_f32_e32 %0, %1, %2":"=v"(r):"v"(a),"v"(b));return r;}
__device__ __forceinline__ float fsub_s(float a,float b){float r;asm("v_sub_f32_e32 %0, %1, %2":"=v"(r):"v"(a),"v"(b));return r;}
typedef float f32x2_t __attribute__((ext_vector_type(2))); typedef __bf16 bf16x2_t __attribute__((ext_vector_type(2)));
__device__ __forceinline__ unsigned cvtpk_s(float lo,float hi){f32x2_t v={lo,hi};bf16x2_t b=__builtin_convertvector(v,bf16x2_t);return __builtin_bit_cast(unsigned,b);}
#define WAIT_BAR(N) asm volatile("s_waitcnt vmcnt(" #N ") lgkmcnt(0)\n\ts_barrier":::"memory")

__device__ __forceinline__ void qkt(f32x16&p0,f32x16&p1,const char*Kslot,const bf16x8*qr,const f32x16&negm,int r32,int hi){
  const char*kb=Kslot+hi*1024+r32*16;
  #pragma unroll
  for(int d0=0;d0<4;++d0){
    const bf16x8 b0=*reinterpret_cast<const bf16x8*>(kb+d0*2048);
    const bf16x8 b1=*reinterpret_cast<const bf16x8*>(kb+d0*2048+512);
    if(d0==0){p0=__builtin_amdgcn_mfma_f32_32x32x16_bf16(b0,qr[0],negm,0,0,0);p1=__builtin_amdgcn_mfma_f32_32x32x16_bf16(b1,qr[0],negm,0,0,0);}
    else{p0=__builtin_amdgcn_mfma_f32_32x32x16_bf16(b0,qr[d0],p0,0,0,0);p1=__builtin_amdgcn_mfma_f32_32x32x16_bf16(b1,qr[d0],p1,0,0,0);}}
}
typedef __attribute__((address_space(3))) const char* lds_cptr;
typedef short v4i16_t __attribute__((ext_vector_type(4)));
__device__ __forceinline__ void kload8(bf16x8*kf,lds_cptr kp){
  kf[0]=*(const __attribute__((address_space(3))) bf16x8*)(kp);      kf[1]=*(const __attribute__((address_space(3))) bf16x8*)(kp+512);
  kf[2]=*(const __attribute__((address_space(3))) bf16x8*)(kp+2048); kf[3]=*(const __attribute__((address_space(3))) bf16x8*)(kp+2560);
  kf[4]=*(const __attribute__((address_space(3))) bf16x8*)(kp+4096); kf[5]=*(const __attribute__((address_space(3))) bf16x8*)(kp+4608);
  kf[6]=*(const __attribute__((address_space(3))) bf16x8*)(kp+6144); kf[7]=*(const __attribute__((address_space(3))) bf16x8*)(kp+6656);
}
__device__ __forceinline__ void kload2(bf16x8*kf,lds_cptr kp,int j){ kf[2*j]=*(const __attribute__((address_space(3))) bf16x8*)(kp+j*2048); kf[2*j+1]=*(const __attribute__((address_space(3))) bf16x8*)(kp+j*2048+512); }
__device__ __forceinline__ s16x4 vtr(lds_cptr p){ return __builtin_bit_cast(s16x4,__builtin_amdgcn_ds_read_tr16_b64_v4i16((__attribute__((address_space(3))) v4i16_t*)p)); }
__device__ __forceinline__ float rowmax(const f32x16&p0,const f32x16&p1){
  float a=max3f(p0[0],p0[1],p1[0]),b=max3f(p0[2],p0[3],p1[1]);a=max3f(a,p1[2],p1[3]);
  #pragma unroll
  for(int r=4;r<16;r+=4){a=max3f(a,p0[r],p0[r+1]);b=max3f(b,p0[r+2],p0[r+3]);a=max3f(a,p1[r],p1[r+1]);b=max3f(b,p1[r+2],p1[r+3]);}
  const float m=max2f(a,b);
  auto rr=__builtin_amdgcn_permlane32_swap(__float_as_uint(m),__float_as_uint(m),false,false);
  return max2f(__uint_as_float(rr[0]),__uint_as_float(rr[1]));
}
__device__ __forceinline__ void pv(f32x16*o,int vb,bf16x8 pa0,bf16x8 pa1,bf16x8 pa2,bf16x8 pa3){
  #pragma unroll
  for(int d0=0;d0<2;++d0){s16x4 lo[4],hi[4];
    #pragma unroll
    for(int ks=0;ks<4;++ks){
      asm volatile("ds_read_b64_tr_b16 %0,%1 offset:%c2":"=&v"(lo[ks]):"v"(vb),"i"(d0*4096+ks*1024):"memory");
      asm volatile("ds_read_b64_tr_b16 %0,%1 offset:%c2":"=&v"(hi[ks]):"v"(vb),"i"(d0*4096+ks*1024+512):"memory");}
    asm volatile("s_waitcnt lgkmcnt(0)":::"memory");SBAR();
    #define PK(k) (bf16x8){lo[k][0],lo[k][1],lo[k][2],lo[k][3],hi[k][0],hi[k][1],hi[k][2],hi[k][3]}
    o[d0]=__builtin_amdgcn_mfma_f32_32x32x16_bf16(pa0,PK(0),o[d0],0,0,0);
    o[d0]=__builtin_amdgcn_mfma_f32_32x32x16_bf16(pa1,PK(1),o[d0],0,0,0);
    o[d0]=__builtin_amdgcn_mfma_f32_32x32x16_bf16(pa2,PK(2),o[d0],0,0,0);
    o[d0]=__builtin_amdgcn_mfma_f32_32x32x16_bf16(pa3,PK(3),o[d0],0,0,0);
    #undef PK
  }
}

#ifndef ATTN_STORE16
#define ATTN_STORE16(p,v) (*(u32x4*)(p)=(v))
#endif
struct Comb { bf16* XA; const float* gh; float lamf, lam_init; };
template<int THRL> __device__ __forceinline__ void attn_unit(int b,int qcol,int vcol,int ocol,int qb,const bf16*Q,const bf16*__restrict__ K,const bf16*__restrict__ V,bf16*O,char*shm,bool comb,const Comb&CB){
  int tid_o=threadIdx.x; asm volatile("":"+v"(tid_o)); const int tid=tid_o,lane=tid&63,r32=lane&31,hi=lane>>5; const int wid=__builtin_amdgcn_readfirstlane(tid>>6);
  const long rowbase=(long)b*SEQ; const int q0=qb*QB;
  const bf16*Qw=Q+(rowbase+q0+wid*QBLK)*DM+qcol;
  const bf16*Kh=K+rowbase*DM+qcol,*Vh=V+rowbase*DM+vcol;
  const unsigned lds0=(unsigned)(uintptr_t)shm;
  float*wsf=(float*)(shm+LDS_WS)+wid*64;
  const bf16*ksrc=Kh+(long)lane*DM+wid*8;
  const bf16*vsrc=Vh+(long)(16*(wid&3)+(lane>>2))*DM+(wid>>2)*32+(lane&3)*8;
  const unsigned kdst=lds0+LDS_K+wid*1024, vdst=lds0+LDS_V+wid*1024;
  #define DMA_K(t,slot) glds16(ksrc+(long)(t)*KVBLK*DM,(unsigned)__builtin_amdgcn_readfirstlane(kdst+(slot)))
  #define DMA_V(t,slot) do{ glds16(vsrc+(long)(t)*KVBLK*DM,(unsigned)__builtin_amdgcn_readfirstlane(vdst+(slot))); glds16(vsrc+64+(long)(t)*KVBLK*DM,(unsigned)__builtin_amdgcn_readfirstlane(vdst+(LDS_V2-LDS_V)+(slot))); }while(0)
  const int vb0=(int)(lds0+LDS_V)+((lane>>4)&1)*32+(lane&3)*8+(4*hi+((lane&15)>>2))*64;
  const char*Kbase=shm+LDS_K; bf16x8 kf[8];
  const lds_cptr shm3=(lds_cptr)shm; const lds_cptr kp0=shm3+LDS_K+hi*1024+r32*16; const lds_cptr vp0=shm3+LDS_V+((lane>>4)&1)*32+(lane&3)*8+(4*hi+((lane&15)>>2))*64;
  const int NT=(q0+QB)/KVBLK;
  DMA_K(0,0);DMA_V(0,0);DMA_K(1,SLOTB);
  bf16x8 qr[4];
  #pragma unroll
  for(int d0=0;d0<4;++d0)qr[d0]=*reinterpret_cast<const bf16x8*>(&Qw[(long)r32*DM+d0*16+hi*8]);
  __attribute__((address_space(3))) char*qst=(__attribute__((address_space(3))) char*)(shm3+LDS_OST+wid*8192+lane*16);
  #pragma unroll
  for(int d0=0;d0<4;++d0)*(__attribute__((address_space(3))) bf16x8*)(qst+d0*1024)=qr[d0];
  #define QRD(k) (*(const __attribute__((address_space(3))) bf16x8*)(qst+(k)*1024))
  float mhat=0.f,l_reg=0.f;f32x16 o[4];o[0]=f32x16{};o[1]=f32x16{};o[2]=f32x16{};o[3]=f32x16{};f32x16 negm=f32x16{};asm volatile("":"+v"(negm));
  const int qrel=wid*QBLK+r32;
  #define CMASK(P0,P1,t) do{int jb_=(t)-(NT-4); if(jb_>=0)cmask(P0,P1,jb_,qrel,hi);}while(0)
  bool resc=false;
  #define START(P0,P1) do{ const float rm=rowmax(P0,P1); resc=false; \
    { const float dl=rm; mhat=fadd_s(mhat,dl); \
      _Pragma("unroll") for(int r=0;r<16;++r){P0[r]=fsub_s(P0[r],dl);P1[r]=fsub_s(P1[r],dl);} \
      _Pragma("unroll") for(int r=0;r<16;++r)negm[r]=-mhat; asm volatile("":"+v"(negm)); } \
    _Pragma("unroll") for(int r=0;r<16;++r)P0[r]=__builtin_amdgcn_exp2f(P0[r]); }while(0)
  #define RESC() do{ if(resc){ asm volatile("s_waitcnt lgkmcnt(0)":::"memory"); \
      _Pragma("unroll") for(int d_=0;d_<4;++d_) _Pragma("unroll") for(int r=0;r<16;++r)o[d_][r]*=wsf[crow(r,hi)]; } }while(0)
  f32x16 pA0,pA1,pB0,pB1;
  int sl_prev=0,sl_cur=0,sl_next=SLOTB;
  #define ROT() do{sl_prev=sl_cur;sl_cur=sl_next;sl_next=(sl_next==(NSLOT-1)*SLOTB)?0:sl_next+SLOTB;}while(0)
  DMA_K(2,2*SLOTB);
  WAIT_BAR(3);
  qkt(pA0,pA1,Kbase,qr,negm,r32,hi);asm volatile("s_nop 15\n\ts_nop 7":"+v"(pA0),"+v"(pA1));CMASK(pA0,pA1,0);
  START(pA0,pA1);
  _Pragma("unroll") for(int r=0;r<16;++r)pA1[r]=__builtin_amdgcn_exp2f(pA1[r]);
  WAIT_BAR(0);
  DMA_K(3,0);DMA_V(1,SLOTB);
  ROT();
  kload8(kf,kp0+sl_cur);
  WAIT_BAR(3);
  s16x4 vlo[8],vhi[8]; u32x4 pw0,pw1,pw2,pw3;
  #define PKW(P,B) cvtpk_s(P[B],P[B+1])
  #define PAF(k) __builtin_bit_cast(bf16x8,pw##k)
  typedef float f32x4_t __attribute__((ext_vector_type(4)));
  #define PAFS(P,b) __builtin_bit_cast(bf16x8,(f32x4_t){P[b],P[(b)+1],P[(b)+2],P[(b)+3]})
  float dummy_pin=0.f;
  #define VFR(i) (bf16x8){vlo[i][0],vlo[i][1],vlo[i][2],vlo[i][3],vhi[i][0],vhi[i][1],vhi[i][2],vhi[i][3]}
  #define PIN(x) asm volatile("":"+v"(x))
  #define MX3(a,b,c) __builtin_fmaxf(__builtin_fmaxf((a),(b)),(c))
  #define GAPA(MF,A0,A1,A2,A3,W0,W1,PW) do{ MF; sacc+=(f32x2_t){A0,A1}; sacc+=(f32x2_t){A2,A3}; PIN(sacc); W0; W1; PIN(PW); SBAR(); }while(0)
  #define EX(v) __builtin_amdgcn_exp2f(v)
  #define GAPB(MF,X,B) do{ MF; X[B]=EX(X[B]); X[B+1]=EX(X[B+1]); X[B+2]=EX(X[B+2]); X[B+3]=EX(X[B+3]); PIN(X); SBAR(); }while(0)
  #define GAPB2(MF,X,B) do{ MF; X[B]=EX(X[B]); X[B+1]=EX(X[B+1]); PIN(X); SBAR(); }while(0)
  #define VRD(i) do{ vlo[i]=vtr(vp_+(((i)>>2)*4096+((i)&3)*1024)); vhi[i]=vtr(vp_+(((i)>>2)*4096+((i)&3)*1024+512)); }while(0)
  #define VRD2(i) do{ vlo[i]=vtr(vp_+((LDS_V2-LDS_V)+((i)>>2)*4096+((i)&3)*1024)); vhi[i]=vtr(vp_+((LDS_V2-LDS_V)+((i)>>2)*4096+((i)&3)*1024+512)); SBAR(); }while(0)
  #define KRD(G,j) do{ if(G){ kload2(kf,kp0+sl_next,j); SBAR(); } }while(0)
  #define STEP(C0,C1,P0,P1,t,GK,GV,GL) do{ SBAR(); \
    const lds_cptr vp_=vp0+sl_prev; \
    VRD(0); SBAR(); f32x2_t sacc={P0[0],P0[1]}; \
    GAPA(C0=__builtin_amdgcn_mfma_f32_32x32x16_bf16(kf[0],qr[0],negm,0,0,0), P0[2],P0[3],P0[4],P0[5],     P0[0]=__uint_as_float(PKW(P0,0)), P0[1]=__uint_as_float(PKW(P0,2)), dummy_pin); \
    VRD(4); SBAR(); GAPA(C1=__builtin_amdgcn_mfma_f32_32x32x16_bf16(kf[1],qr[0],negm,0,0,0), P0[6],P0[7],P0[8],P0[9],     P0[2]=__uint_as_float(PKW(P0,4)), P0[3]=__uint_as_float(PKW(P0,6)), dummy_pin); \
    VRD(1); SBAR(); const bf16x8 qq1_=QRD(1); GAPA(C0=__builtin_amdgcn_mfma_f32_32x32x16_bf16(kf[2],qq1_,C0,0,0,0),   P0[10],P0[11],P0[12],P0[13], P0[4]=__uint_as_float(PKW(P0,8)), P0[5]=__uint_as_float(PKW(P0,10)), dummy_pin); \
    VRD(5); SBAR(); GAPA(C1=__builtin_amdgcn_mfma_f32_32x32x16_bf16(kf[3],qq1_,C1,0,0,0),   P0[14],P0[15],P1[0],P1[1],   P0[6]=__uint_as_float(PKW(P0,12)), P0[7]=__uint_as_float(PKW(P0,14)), dummy_pin); \
    VRD(2); SBAR(); const bf16x8 qq2_=QRD(2); GAPA(C0=__builtin_amdgcn_mfma_f32_32x32x16_bf16(kf[4],qq2_,C0,0,0,0),   P1[2],P1[3],P1[4],P1[5],     P1[0]=__uint_as_float(PKW(P1,0)), P1[1]=__uint_as_float(PKW(P1,2)), dummy_pin); \
    VRD(6); SBAR(); GAPA(C1=__builtin_amdgcn_mfma_f32_32x32x16_bf16(kf[5],qq2_,C1,0,0,0),   P1[6],P1[7],P1[8],P1[9],     P1[2]=__uint_as_float(PKW(P1,4)), P1[3]=__uint_as_float(PKW(P1,6)), dummy_pin); \
    VRD(3); SBAR(); const bf16x8 qq3_=QRD(3); GAPA(C0=__builtin_amdgcn_mfma_f32_32x32x16_bf16(kf[6],qq3_,C0,0,0,0),   P1[10],P1[11],P1[12],P1[13], P1[4]=__uint_as_float(PKW(P1,8)), P1[5]=__uint_as_float(PKW(P1,10)), dummy_pin); \
    VRD(7); SBAR(); GAPA(C1=__builtin_amdgcn_mfma_f32_32x32x16_bf16(kf[7],qq3_,C1,0,0,0),   P1[14],P1[15],0.f,0.f,       P1[6]=__uint_as_float(PKW(P1,12)), P1[7]=__uint_as_float(PKW(P1,14)), dummy_pin); \
    l_reg+=sacc.x+sacc.y; \
    if(GK){DMA_K((t)+3,sl_cur);} if(GV){DMA_V((t)+1,sl_next);} \
    CMASK(C0,C1,t); \
    { float a=MX3(C0[0],C0[1],C1[0]),b=MX3(C0[2],C0[3],C1[1]); a=MX3(a,C1[2],C1[3]); \
      _Pragma("unroll") for(int r=4;r<16;r+=4){a=MX3(a,C0[r],C0[r+1]);b=MX3(b,C0[r+2],C0[r+3]);a=MX3(a,C1[r],C1[r+1]);b=MX3(b,C1[r+2],C1[r+3]);} \
      float rm=__builtin_fmaxf(a,b); { auto rr=__builtin_amdgcn_permlane32_swap(__float_as_uint(rm),__float_as_uint(rm),false,false); rm=__builtin_fmaxf(__uint_as_float(rr[0]),__uint_as_float(rr[1])); } \
      resc=false; \
      if(__builtin_expect(__any(rm>(float)THRL),0)){ const float dl=__builtin_fmaxf(rm,0.f); mhat+=dl; \
        _Pragma("unroll") for(int r=0;r<16;++r){C0[r]-=dl;C1[r]-=dl;} \
        _Pragma("unroll") for(int r=0;r<16;++r)negm[r]=-mhat; asm volatile("":"+v"(negm)); \
        const float f=__builtin_amdgcn_exp2f(-dl); l_reg*=f; if(hi==0)wsf[r32]=f; resc=true; } } \
    SBAR(); \
    GAPB2(o[0]=__builtin_amdgcn_mfma_f32_32x32x16_bf16(PAFS(P0,0),VFR(0),o[0],0,0,0), C0,0); VRD2(0); \
    GAPB2(o[1]=__builtin_amdgcn_mfma_f32_32x32x16_bf16(PAFS(P0,0),VFR(4),o[1],0,0,0), C0,2); VRD2(4); \
    KRD(GL,0); GAPB2(o[0]=__builtin_amdgcn_mfma_f32_32x32x16_bf16(PAFS(P0,4),VFR(1),o[0],0,0,0), C0,4); VRD2(1); \
    KRD(GL,1); GAPB2(o[1]=__builtin_amdgcn_mfma_f32_32x32x16_bf16(PAFS(P0,4),VFR(5),o[1],0,0,0), C0,6); VRD2(5); \
    KRD(GL,2); GAPB2(o[0]=__builtin_amdgcn_mfma_f32_32x32x16_bf16(PAFS(P1,0),VFR(2),o[0],0,0,0), C0,8); VRD2(2); \
    KRD(GL,3); GAPB2(o[1]=__builtin_amdgcn_mfma_f32_32x32x16_bf16(PAFS(P1,0),VFR(6),o[1],0,0,0), C0,10); VRD2(6); \
    GAPB2(o[0]=__builtin_amdgcn_mfma_f32_32x32x16_bf16(PAFS(P1,4),VFR(3),o[0],0,0,0), C0,12); VRD2(3); \
    GAPB2(o[1]=__builtin_amdgcn_mfma_f32_32x32x16_bf16(PAFS(P1,4),VFR(7),o[1],0,0,0), C0,14); VRD2(7); \
    GAPB2(o[2]=__builtin_amdgcn_mfma_f32_32x32x16_bf16(PAFS(P0,0),VFR(0),o[2],0,0,0), C1,0); \
    GAPB2(o[3]=__builtin_amdgcn_mfma_f32_32x32x16_bf16(PAFS(P0,0),VFR(4),o[3],0,0,0), C1,2); \
    GAPB2(o[2]=__builtin_amdgcn_mfma_f32_32x32x16_bf16(PAFS(P0,4),VFR(1),o[2],0,0,0), C1,4); \
    GAPB2(o[3]=__builtin_amdgcn_mfma_f32_32x32x16_bf16(PAFS(P0,4),VFR(5),o[3],0,0,0), C1,6); \
    GAPB2(o[2]=__builtin_amdgcn_mfma_f32_32x32x16_bf16(PAFS(P1,0),VFR(2),o[2],0,0,0), C1,8); \
    GAPB2(o[3]=__builtin_amdgcn_mfma_f32_32x32x16_bf16(PAFS(P1,0),VFR(6),o[3],0,0,0), C1,10); \
    GAPB2(o[2]=__builtin_amdgcn_mfma_f32_32x32x16_bf16(PAFS(P1,4),VFR(3),o[2],0,0,0), C1,12); \
    GAPB2(o[3]=__builtin_amdgcn_mfma_f32_32x32x16_bf16(PAFS(P1,4),VFR(7),o[3],0,0,0), C1,14); \
    }while(0)
  int t=1;
  #undef CMASK
  #define CMASK(P0,P1,t) do{}while(0)
  for(;t+5<NT;t+=2){
    STEP(pB0,pB1,pA0,pA1,t,true,true,true);     WAIT_BAR(3); RESC(); ROT();
    STEP(pA0,pA1,pB0,pB1,t+1,true,true,true);   WAIT_BAR(3); RESC(); ROT();
  }
  #undef CMASK
  #define CMASK(P0,P1,t) do{int jb_=(t)-(NT-4); if(jb_>=0)cmask(P0,P1,jb_,qrel,hi);}while(0)
  #define ENDW(tt) do{ if((tt)+3<NT){WAIT_BAR(3);} else if((tt)+2<NT){WAIT_BAR(2);} else {WAIT_BAR(0);} }while(0)
  for(;t+1<NT;t+=2){
    STEP(pB0,pB1,pA0,pA1,t,(t+3<NT),(t+1<NT),(t+1<NT));       ENDW(t);   RESC(); ROT();
    STEP(pA0,pA1,pB0,pB1,t+1,(t+4<NT),(t+2<NT),(t+2<NT));     ENDW(t+1); RESC(); ROT();
  }
  STEP(pB0,pB1,pA0,pA1,NT-1,false,false,false); RESC();
  { float sacc=pB0[0]+pB0[1]; _Pragma("unroll") for(int r=2;r<16;++r)sacc+=pB0[r]; _Pragma("unroll") for(int r=0;r<16;++r)sacc+=pB1[r]; l_reg+=sacc;
    pw0=(u32x4){PKW(pB0,0),PKW(pB0,2),PKW(pB0,4),PKW(pB0,6)};pw1=(u32x4){PKW(pB0,8),PKW(pB0,10),PKW(pB0,12),PKW(pB0,14)};pw2=(u32x4){PKW(pB1,0),PKW(pB1,2),PKW(pB1,4),PKW(pB1,6)};pw3=(u32x4){PKW(pB1,8),PKW(pB1,10),PKW(pB1,12),PKW(pB1,14)};
    SBAR(); pv(o,vb0+sl_cur,PAF(0),PAF(1),PAF(2),PAF(3)); pv(o+2,vb0+(LDS_V2-LDS_V)+sl_cur,PAF(0),PAF(1),PAF(2),PAF(3)); }
  #undef PKW
  #undef PAF
  #undef PAFS
  #undef VFR
  #undef PIN
  #undef MX3
  #undef GAPA
  #undef GAPB
  #undef GAPB2
  #undef EX
  #undef VRD
  #undef VRD2
  #undef QRD
  #undef KRD
  #undef STEP
  #undef ENDW
  {auto rr=__builtin_amdgcn_permlane32_swap(__float_as_uint(l_reg),__float_as_uint(l_reg),false,false);l_reg=__uint_as_float(rr[0])+__uint_as_float(rr[1]);}
  if(hi==0)wsf[32+r32]=l_reg;asm volatile("s_waitcnt lgkmcnt(0)":::"memory");
  float rli[16];
  #pragma unroll
  for(int r=0;r<16;++r)rli[r]=__builtin_amdgcn_rcpf(wsf[32+crow(r,hi)]);
  bf16*Ow=O+(rowbase+q0+wid*QBLK)*OPITCH+ocol;
  { bf16*stg=(bf16*)(shm+LDS_OST)+wid*4096;
    #pragma unroll
    for(int r=0;r<16;++r){const int orow=crow(r,hi);
      #pragma unroll
      for(int d0=0;d0<4;++d0)stg[orow*128+d0*32+r32]=__float2bfloat16(o[d0][r]*rli[r]);}
    asm volatile("s_waitcnt lgkmcnt(0)":::"memory");
    if(!comb){
      #pragma unroll
      for(int i=0;i<8;++i){const int row=i*4+(lane>>4),ch=lane&15; const u32x4 v=*(const u32x4*)(stg+row*128+ch*8); ATTN_STORE16(Ow+(long)row*OPITCH+ch*8,v);}
    } else {
      const int hcol=(ocol>>8)*128; const float post=1.f-CB.lam_init;
      #pragma unroll
      for(int i=0;i<8;++i){const int row=i*4+(lane>>4),ch=lane&15;
        const u32x4 v1=*(const u32x4*)(stg+row*128+ch*8); const u32x4 v0=*(const u32x4*)(Ow-128+(long)row*OPITCH+ch*8);
        float d[8]; float ss=0.f;
        #pragma unroll
        for(int w=0;w<4;++w){ d[2*w]=__uint_as_float(v0[w]<<16)-CB.lamf*__uint_as_float(v1[w]<<16); d[2*w+1]=__uint_as_float(v0[w]&0xffff0000u)-CB.lamf*__uint_as_float(v1[w]&0xffff0000u); ss+=d[2*w]*d[2*w]+d[2*w+1]*d[2*w+1]; }
        _Pragma("unroll") for(int sx=1;sx<16;sx<<=1) ss+=__int_as_float(__builtin_amdgcn_ds_bpermute((lane^sx)<<2,__float_as_int(ss)));
        const float rn=rsqrtf(ss*(1.f/128.f)+1e-6f)*post;
        const float*gp=CB.gh+hcol+ch*8; const float4 g0=*(const float4*)gp,g1=*(const float4*)(gp+4);
        u32x4 ov; ov[0]=cvtpk_s(d[0]*rn*g0.x,d[1]*rn*g0.y); ov[1]=cvtpk_s(d[2]*rn*g0.z,d[3]*rn*g0.w); ov[2]=cvtpk_s(d[4]*rn*g1.x,d[5]*rn*g1.y); ov[3]=cvtpk_s(d[6]*rn*g1.z,d[7]*rn*g1.w);
        *(u32x4*)(CB.XA+(rowbase+q0+wid*QBLK+row)*DM+hcol+ch*8)=ov; }
    } }
  asm volatile("s_waitcnt lgkmcnt(0)\n\ts_barrier":::"memory");
  #undef DMA_K
  #undef DMA_V
  #undef CMASK
  #undef START
  #undef RESC
  #undef ROT
}
constexpr int ATTN_LDS_BYTES=LDS_BYTES;
struct AttnTensors { const bf16* Q; const bf16* K; const bf16* V; bf16* O; };
template<int THRL=8> __device__ __forceinline__ void attn_phase(char*lds,const AttnTensors&T,const Comb&CB,int grid,int block){
  const bool fast=(grid==256);
  for(int i=0;;++i){
    int bh,j;
    if(fast){ if(i>=8)break; bh=(i>>2)*8+(block&7); j=block>>3; }
    else { const long p=(long)(i>>2)*grid+block; if(p>=16*32)break; bh=(int)(p>>5); j=(int)(p&31); }
    const int c=i&1, qb=(i&2)?(NQB-1-j):j, b=bh>>3, vh=(bh&7)*2+c;
    attn_unit<THRL>(b,vh*64,(vh>>1)*128,vh*128,qb,T.Q,T.K,T.V,T.O,lds,c==1,CB);
  }
}
#undef SBAR
#undef WAIT_BAR
}

namespace cg = cooperative_groups;
#define LAS __attribute__((address_space(3)))
typedef unsigned short bf16;
typedef unsigned v4u __attribute__((ext_vector_type(4)));
typedef unsigned v2u __attribute__((ext_vector_type(2)));
typedef float f32x4 __attribute__((ext_vector_type(4)));
typedef short bf16x8 __attribute__((ext_vector_type(8)));
#ifndef PROBE_ATTN
#define PROBE_ATTN 1
#endif
#ifndef PROBE_GEMM
#define PROBE_GEMM 1
#endif
#ifndef PROBE_M
#define PROBE_M 1
#endif
#ifndef MK_MULTI
#define MK_MULTI 0
#endif
constexpr int NWAVES = 8, NTHR = 512;
constexpr int BATCH = 2, SEQ = 16384, DM = 1024, TT = BATCH * SEQ, FF = 4096;
constexpr int MPROJ = 3080, NPROJ = 3072;
constexpr float EPS = 1e-6f;
constexpr float KSCALE = 0.08838834764831845f;
constexpr int NPH = 33;
constexpr size_t MiB = 1u << 20;
constexpr size_t WS_WA = 2 * MiB, WS_WO = 8 * MiB, WS_WU = 10 * MiB, WS_WD = 18 * MiB;
constexpr size_t WS_XN = 32 * MiB;
constexpr size_t WS_K = 96 * MiB, WS_V = 160 * MiB;
constexpr size_t WS_PROJ = 96 * MiB;
constexpr size_t WS_ST = 288 * MiB;
constexpr size_t WS_YA = 416 * MiB;
constexpr size_t WS_Q = 224 * MiB;
constexpr size_t WS_O = 288 * MiB;
constexpr size_t WS_H = 224 * MiB;
constexpr size_t WS_ROPE = 480 * MiB;
constexpr size_t WS_G = 488 * MiB;
constexpr size_t WS_DEC = 489 * MiB;
constexpr size_t WS_NST = 490 * MiB;
constexpr size_t WS_END = 491 * MiB;
constexpr int CW_BAR = 4096;
constexpr size_t CTL_ZERO_BYTES = 65536;
constexpr int LDS_BYTES = 147456;

struct Args {
    const float* x; const int* pos; const float* norm_g; const float* a_w_in; const float* a_b_gates; const float* a_g_head; const float* a_w_out;
    const float* kv_norm_g; const float* w_kv; const float* b_w_q; const float* b_lam; const float* b_g_head; const float* b_w_out;
    const float* mlp_up; const float* mlp_down; float* out; unsigned char* ws;
    float lam_init[2]; int ph_lo_, ph_hi_;
};

__device__ __forceinline__ unsigned f2bf(float f) { unsigned u = __builtin_bit_cast(unsigned, f); return (u + 0x7fffu + ((u >> 16) & 1u)) >> 16; }
__device__ __forceinline__ unsigned pk2(float lo, float hi) { return f2bf(lo) | (f2bf(hi) << 16); }
__device__ __forceinline__ float bflo(unsigned w) { return __uint_as_float(w << 16); }
__device__ __forceinline__ float bfhi(unsigned w) { return __uint_as_float(w & 0xffff0000u); }
__device__ __forceinline__ float shx(float v, int o, int lane) { return __int_as_float(__builtin_amdgcn_ds_bpermute((lane ^ o) << 2, __float_as_int(v))); }
__device__ __forceinline__ float shl_(float v, int src) { return __int_as_float(__builtin_amdgcn_ds_bpermute(src << 2, __float_as_int(v))); }
__device__ __forceinline__ float wave_sum(float v, int lane) {
#pragma unroll
    for (int o = 1; o < 64; o <<= 1) v += shx(v, o, lane);
    return v;
}
__device__ __forceinline__ float fexp(float x) { return __builtin_amdgcn_exp2f(x * 1.4426950408889634f); }
#define MFMA16(a, b, c) __builtin_amdgcn_mfma_f32_16x16x32_bf16((a), (b), (c), 0, 0, 0)

__device__ __forceinline__ int rope_perm(int c) { const int w = c & 63; return (c & ~63) + 8 * ((w & 31) >> 2) + 4 * (w >> 5) + (w & 3); }
__device__ __forceinline__ void transpose_item(const float* W, int K, int ldw, int N, bf16* WT, LAS float* scr, int item, int lane, int perm_lim) {
    const int nblk = N / 32, kb = item / nblk, nb = item % nblk, k0 = 64 * kb, n0 = 32 * nb;
    float wv[32];
#pragma unroll
    for (int i = 0; i < 32; ++i) wv[i] = W[(size_t)(k0 + 2 * i + (lane >> 5)) * ldw + n0 + (lane & 31)];
#pragma unroll
    for (int i = 0; i < 32; ++i) scr[(2 * i + (lane >> 5)) * 33 + (lane & 31)] = wv[i];
    asm volatile("s_waitcnt lgkmcnt(0)" ::: "memory");
    const int c = lane & 7;
#pragma unroll
    for (int j = 0; j < 4; ++j) { const int n = (lane >> 3) + 8 * j; const LAS float* s = scr + (8 * c) * 33 + n;
        v4u o; o.x = pk2(s[0 * 33], s[1 * 33]); o.y = pk2(s[2 * 33], s[3 * 33]); o.z = pk2(s[4 * 33], s[5 * 33]); o.w = pk2(s[6 * 33], s[7 * 33]);
        const int nn = n0 + n, nd = (nn < perm_lim) ? rope_perm(nn) : nn;
        *(v4u*)(WT + (size_t)nd * K + k0 + 8 * c) = o; }
    asm volatile("s_waitcnt lgkmcnt(0)" ::: "memory");
}
__device__ __forceinline__ void conv_weights(const Args& a, int L, LAS unsigned char* lds, int gw, int NGW, int wave, int lane) {
    LAS float* scr = (LAS float*)(lds + wave * 16384);
    unsigned char* ws = a.ws;
    const float* W0; int K0, ld0, N0; const float* W1 = nullptr; int N1 = 0, ld1 = 0;
    const float* Wo;
    if (L < 2) { W0 = a.a_w_in + (size_t)L * DM * MPROJ; K0 = DM; ld0 = MPROJ; N0 = NPROJ; Wo = a.a_w_out + (size_t)L * DM * DM; }
    else { W0 = a.b_w_q + (size_t)(L - 2) * DM * DM; K0 = DM; ld0 = DM; N0 = DM; Wo = a.b_w_out + (size_t)(L - 2) * DM * DM; if (L == 2) { W1 = a.w_kv; N1 = 2 * DM; ld1 = 2 * DM; } }
    const float* Wu = a.mlp_up + (size_t)L * DM * FF; const float* Wd = a.mlp_down + (size_t)L * FF * DM;
    const int I0 = (K0 / 64) * (N0 / 32), I1 = (DM / 64) * (N1 / 32), IO = (DM / 64) * (DM / 32), IU = (DM / 64) * (FF / 32), ID = (FF / 64) * (DM / 32);
    const int NIT = I0 + I1 + IO + IU + ID;
    for (int it = gw; it < NIT; it += NGW) {
        int r = it;
        if (r < I0) { transpose_item(W0, K0, ld0, N0, (bf16*)(ws + WS_WA), scr, r, lane, (L >= 2) ? DM : 0); continue; } r -= I0;
        if (r < I1) { transpose_item(W1, DM, ld1, N1, (bf16*)(ws + WS_WA) + (size_t)DM * DM, scr, r, lane, DM); continue; } r -= I1;
        if (r < IO) { transpose_item(Wo, DM, DM, DM, (bf16*)(ws + WS_WO), scr, r, lane, 0); continue; } r -= IO;
        if (r < IU) { transpose_item(Wu, DM, FF, FF, (bf16*)(ws + WS_WU), scr, r, lane, 0); continue; } r -= IU;
        transpose_item(Wd, FF, DM, DM, (bf16*)(ws + WS_WD), scr, r, lane, 0);
    }
}

__device__ __forceinline__ void rope_table(const int* pos, float* tab, int gtid, int nthr) {
    for (int idx = gtid; idx < TT * 32; idx += nthr) {
        const int t = idx >> 5, i = idx & 31;
        double p = 1.0;
        for (int k = 0; k < i; ++k) p *= 1.333521432163324;
        const float inv = 1.0f / (float)p;
        const float ang = (float)pos[t] * inv;
        const double rev = (double)ang * 0.15915494309189535;
        const double fr = rev - rint(rev);
        const double q = rint(fr * 4.0);
        const float r = (float)((fr - q * 0.25) * 6.283185307179586);
        const float r2 = r * r;
        const float sn = r * (1.f + r2 * (-1.f / 6.f + r2 * (1.f / 120.f + r2 * (-1.f / 5040.f + r2 * (1.f / 362880.f)))));
        const float cs = 1.f + r2 * (-0.5f + r2 * (1.f / 24.f + r2 * (-1.f / 720.f + r2 * (1.f / 40320.f))));
        const int qi = ((int)q) & 3;
        const float c = (qi == 0) ? cs : (qi == 1) ? -sn : (qi == 2) ? -cs : sn;
        const float s = (qi == 0) ? sn : (qi == 1) ? cs : (qi == 2) ? -sn : -cs;
        tab[(size_t)t * 64 + i] = c; tab[(size_t)t * 64 + 32 + i] = s;
    }
}

struct NormJob { const float* xin; float* xout; const bf16* Y; const float* gpost; const float* gpre; bf16* XN; const float* gkv; bf16* XKV; const float* wg; const float* bg; float* G; };
__device__ __forceinline__ float softcap15(float z) { const float e = fexp(fminf(z * (2.f / 15.f), 80.f)); return 15.f * ((e - 1.f) / (e + 1.f)); }
__device__ __forceinline__ void norm_phase(const NormJob& J, LAS unsigned char* lds, int gw, int NGW, int tid, int lane) {
    LAS float* wl = (LAS float*)lds;
    if (J.wg) {
        for (int i = tid; i < 8192; i += NTHR) { const int d = i >> 3, q = i & 7; wl[q * 1024 + d] = J.wg[(size_t)d * MPROJ + q]; }
        __syncthreads();
    }
    constexpr int NR = 2;
    f32x4 nxv[2][NR][4]; v2u nyw[2][NR][4];
#pragma unroll
    for (int d = 0; d < 2; ++d)
#pragma unroll
        for (int r = 0; r < NR; ++r)
#pragma unroll
            for (int j = 0; j < 4; ++j) { nxv[d][r][j] = (f32x4){0.f, 0.f, 0.f, 0.f}; nyw[d][r][j] = (v2u){0u, 0u}; }
#pragma unroll
    for (int d = 0; d < 2; ++d) { const int mf = gw * NR + d * NGW * NR;
        if (mf < TT) {
#pragma unroll
            for (int r = 0; r < NR; ++r)
#pragma unroll
                for (int j = 0; j < 4; ++j) nxv[d][r][j] = __builtin_nontemporal_load((const f32x4*)(J.xin + (size_t)(mf + r) * DM) + lane + 64 * j);
            if (J.Y) {
#pragma unroll
                for (int r = 0; r < NR; ++r)
#pragma unroll
                    for (int j = 0; j < 4; ++j) nyw[d][r][j] = __builtin_nontemporal_load((const v2u*)(J.Y + (size_t)(mf + r) * DM) + lane + 64 * j); }
        } }
    for (int m0 = gw * NR; m0 < TT; m0 += NGW * NR) {
        f32x4 v[NR][4]; v2u yw[NR][4];
#pragma unroll
        for (int r = 0; r < NR; ++r)
#pragma unroll
            for (int j = 0; j < 4; ++j) { v[r][j] = nxv[0][r][j]; yw[r][j] = nyw[0][r][j]; nxv[0][r][j] = nxv[1][r][j]; nyw[0][r][j] = nyw[1][r][j]; }
        { const int m2 = m0 + 2 * NGW * NR;
          if (m2 < TT) {
#pragma unroll
            for (int r = 0; r < NR; ++r)
#pragma unroll
                for (int j = 0; j < 4; ++j) nxv[1][r][j] = __builtin_nontemporal_load((const f32x4*)(J.xin + (size_t)(m2 + r) * DM) + lane + 64 * j);
            if (J.Y) {
#pragma unroll
                for (int r = 0; r < NR; ++r)
#pragma unroll
                    for (int j = 0; j < 4; ++j) nyw[1][r][j] = __builtin_nontemporal_load((const v2u*)(J.Y + (size_t)(m2 + r) * DM) + lane + 64 * j); }
          } }
        if (J.Y) {
            float s[NR];
            f32x4 y[NR][4];
#pragma unroll
            for (int r = 0; r < NR; ++r) { s[r] = 0.f;
#pragma unroll
                for (int j = 0; j < 4; ++j) { const v2u w = yw[r][j]; y[r][j] = (f32x4){bflo(w.x), bfhi(w.x), bflo(w.y), bfhi(w.y)}; s[r] += (y[r][j].x * y[r][j].x + y[r][j].y * y[r][j].y) + (y[r][j].z * y[r][j].z + y[r][j].w * y[r][j].w); } }
#pragma unroll
            for (int o = 1; o < 64; o <<= 1) {
#pragma unroll
                for (int r = 0; r < NR; ++r) s[r] += shx(s[r], o, lane); }
#pragma unroll
            for (int r = 0; r < NR; ++r) { const float rr = rsqrtf(s[r] * (1.f / DM) + EPS);
                f32x4* xo = (f32x4*)(J.xout + (size_t)(m0 + r) * DM) + lane;
#pragma unroll
                for (int j = 0; j < 4; ++j) { const f32x4 gp = ((const f32x4*)J.gpost)[lane + 64 * j]; v[r][j] = v[r][j] + y[r][j] * rr * gp; __builtin_nontemporal_store(v[r][j], xo + 64 * j); } }
        }
        if (J.gpre) {
            float s2[NR];
#pragma unroll
            for (int r = 0; r < NR; ++r) { s2[r] = 0.f;
#pragma unroll
                for (int j = 0; j < 4; ++j) s2[r] += (v[r][j].x * v[r][j].x + v[r][j].y * v[r][j].y) + (v[r][j].z * v[r][j].z + v[r][j].w * v[r][j].w); }
#pragma unroll
            for (int o = 1; o < 64; o <<= 1) {
#pragma unroll
                for (int r = 0; r < NR; ++r) s2[r] += shx(s2[r], o, lane); }
#pragma unroll
            for (int r = 0; r < NR; ++r) { const int m = m0 + r;
                const float r2 = rsqrtf(s2[r] * (1.f / DM) + EPS);
                v2u* xn = (v2u*)(J.XN + (size_t)m * DM) + lane;
                f32x4 hn[4];
#pragma unroll
                for (int j = 0; j < 4; ++j) { const f32x4 g = ((const f32x4*)J.gpre)[lane + 64 * j]; hn[j] = v[r][j] * r2 * g; v2u w; w.x = pk2(hn[j].x, hn[j].y); w.y = pk2(hn[j].z, hn[j].w); xn[64 * j] = w; }
                if (J.gkv) {
                    v2u* xk = (v2u*)(J.XKV + (size_t)m * DM) + lane;
#pragma unroll
                    for (int j = 0; j < 4; ++j) { const f32x4 g = ((const f32x4*)J.gkv)[lane + 64 * j]; const f32x4 hk = v[r][j] * r2 * g; v2u w; w.x = pk2(hk.x, hk.y); w.y = pk2(hk.z, hk.w); xk[64 * j] = w; }
                }
                if (J.wg) {
                    float ga[8];
#pragma unroll
                    for (int q = 0; q < 8; ++q) { float sq = 0.f;
#pragma unroll
                        for (int j = 0; j < 4; ++j) { const f32x4 w = *(const LAS f32x4*)(wl + q * 1024 + 4 * lane + 256 * j); sq += (hn[j].x * w.x + hn[j].y * w.y) + (hn[j].z * w.z + hn[j].w * w.w); }
                        ga[q] = sq; }
#pragma unroll
                    for (int o = 1; o < 64; o <<= 1) {
#pragma unroll
                        for (int q = 0; q < 8; ++q) ga[q] += shx(ga[q], o, lane); }
                    const int q = lane & 7;
                    float z = (q == 0) ? ga[0] : (q == 1) ? ga[1] : (q == 2) ? ga[2] : (q == 3) ? ga[3] : (q == 4) ? ga[4] : (q == 5) ? ga[5] : (q == 6) ? ga[6] : ga[7];
                    z = softcap15(z + J.bg[q]);
                    if (q >= 4) z = fminf(z, 0.f) - __logf(1.f + fexp(-fabsf(z)));
                    if (lane < 8) J.G[(size_t)m * 8 + q] = z;
                }
            }
        }
    }
}

constexpr int VTP = 144;
constexpr int QP = 272;
constexpr int APP = 400;
constexpr int HSP = 260;

__device__ __forceinline__ unsigned elem16(const v4u& v, int i) { return (v[i >> 1] >> (16 * (i & 1))) & 0xffffu; }

__device__ __forceinline__ void m1_phase(LAS unsigned char* lds, const bf16* proj, const float* Gt, bf16* ST, float* dec, float* nst, int nblk, int bx, int tid, int lane, int wave) {
    LAS unsigned char* vT = lds; LAS unsigned char* kT = lds + 36864; LAS float* wsv = (LAS float*)(lds + 55296);
    const int fr = lane & 15, fg = lane >> 4, lp = tid & 31, pcg = tid >> 5;
    for (int unit = bx; unit < 2048; unit += nblk) {
        const int b = unit >> 10, h = (unit >> 8) & 3, c = unit & 255; const size_t t0 = (size_t)b * SEQ + (size_t)c * 64;
        if (wave == 0) {
            const float lf = Gt[(t0 + lane) * 8 + 4 + h], li = Gt[(t0 + lane) * 8 + h];
            float bs = lf;
#pragma unroll
            for (int o = 1; o < 64; o <<= 1) { const float t = shl_(bs, lane - o); if (lane >= o) bs += t; }
            const float bl = shl_(bs, 63);
            wsv[lane] = fexp(bl - bs + li) * KSCALE;
            if (lane == 63) dec[unit] = fexp(bl);
        }
        const bf16* r0 = proj + (t0 + 2 * lp) * NPROJ; const bf16* r1 = r0 + NPROJ;
        v4u va[2], vb[2];
#pragma unroll
        for (int n = 0; n < 2; ++n) { va[n] = *(const v4u*)(r0 + 1024 + h * 256 + 8 * (pcg + 16 * n)); vb[n] = *(const v4u*)(r1 + 1024 + h * 256 + 8 * (pcg + 16 * n)); }
        const v4u ka = *(const v4u*)(r0 + 512 + h * 128 + 8 * pcg), kb = *(const v4u*)(r1 + 512 + h * 128 + 8 * pcg);
        __syncthreads();
#pragma unroll
        for (int n = 0; n < 2; ++n)
#pragma unroll
            for (int i = 0; i < 8; ++i) *(LAS unsigned*)(vT + (8 * (pcg + 16 * n) + i) * VTP + lp * 4) = elem16(va[n], i) | (elem16(vb[n], i) << 16);
        const float w0 = wsv[2 * lp], w1 = wsv[2 * lp + 1];
#pragma unroll
        for (int i = 0; i < 8; ++i) *(LAS unsigned*)(kT + (8 * pcg + i) * VTP + lp * 4) = f2bf(__uint_as_float(elem16(ka, i) << 16) * w0) | (f2bf(__uint_as_float(elem16(kb, i) << 16) * w1) << 16);
        __syncthreads();
        f32x4 acc[2][8];
#pragma unroll
        for (int mt = 0; mt < 2; ++mt)
#pragma unroll
            for (int nt = 0; nt < 8; ++nt) acc[mt][nt] = (f32x4){0.f, 0.f, 0.f, 0.f};
#pragma unroll
        for (int ks = 0; ks < 2; ++ks) {
            bf16x8 vf[2];
#pragma unroll
            for (int mt = 0; mt < 2; ++mt) vf[mt] = *(const LAS bf16x8*)(vT + (32 * wave + 16 * mt + fr) * VTP + (32 * ks + 8 * fg) * 2);
#pragma unroll
            for (int nt = 0; nt < 8; ++nt) { const bf16x8 kf = *(const LAS bf16x8*)(kT + (16 * nt + fr) * VTP + (32 * ks + 8 * fg) * 2);
#pragma unroll
                for (int mt = 0; mt < 2; ++mt) acc[mt][nt] = MFMA16(kf, vf[mt], acc[mt][nt]); }
        }
        bf16* sp = ST + (size_t)unit * 32768;
        {
            LAS unsigned char* stg = lds + 57344 + wave * 8704;
#pragma unroll
            for (int mt = 0; mt < 2; ++mt)
#pragma unroll
                for (int nt = 0; nt < 8; ++nt) { v2u w; w.x = pk2(acc[mt][nt][0], acc[mt][nt][1]); w.y = pk2(acc[mt][nt][2], acc[mt][nt][3]);
                    *(LAS v2u*)(stg + (16 * mt + fr) * 272 + (16 * nt + 4 * fg) * 2) = w; }
#pragma unroll
            for (int i = 0; i < 8; ++i) { const int chunk = lane + 64 * i, row = chunk >> 4, ch = chunk & 15;
                const v4u v = *(const LAS v4u*)(stg + row * 272 + ch * 16);
                *(v4u*)(sp + (32 * wave + row) * 128 + ch * 8) = v; }
        }
        if (tid < 128) { float s = 0.f;
#pragma unroll
            for (int i = 0; i < 8; ++i) { const v4u w = *(const LAS v4u*)(kT + tid * VTP + i * 16);
#pragma unroll
                for (int e = 0; e < 4; ++e) s += bflo(w[e]) + bfhi(w[e]); }
            nst[(size_t)unit * 128 + tid] = s; }
        __syncthreads();
    }
}

__device__ __forceinline__ void m2_phase(bf16* ST, const float* dec, float* nst, int gtid, int nthr) {
    for (int chain = gtid; chain < 8 * 16384; chain += nthr) {
        const int bh = chain >> 14, idx = chain & 16383;
        unsigned* p = (unsigned*)ST + (size_t)bh * 256 * 16384 + idx; const float* dc = dec + bh * 256;
        float r0 = 0.f, r1 = 0.f;
        for (int c0 = 0; c0 < 256; c0 += 32) {
            unsigned v[32];
#pragma unroll
            for (int i = 0; i < 32; ++i) v[i] = p[(size_t)(c0 + i) * 16384];
#pragma unroll
            for (int i = 0; i < 32; ++i) { const float d = dc[c0 + i]; p[(size_t)(c0 + i) * 16384] = pk2(r0, r1); r0 = d * r0 + bflo(v[i]); r1 = d * r1 + bfhi(v[i]); }
        }
    }
    for (int chain = gtid; chain < 8 * 128; chain += nthr) {
        const int bh = chain >> 7, d = chain & 127;
        float* p = nst + (size_t)bh * 256 * 128 + d; const float* dc = dec + bh * 256;
        float r = 0.f;
        for (int c0 = 0; c0 < 256; c0 += 16) {
            float v[16];
#pragma unroll
            for (int i = 0; i < 16; ++i) v[i] = p[(c0 + i) * 128];
#pragma unroll
            for (int i = 0; i < 16; ++i) { const float dd = dc[c0 + i]; p[(c0 + i) * 128] = r; r = dd * r + v[i]; }
        }
    }
}

__device__ __forceinline__ void m3_phase(LAS unsigned char* lds, const bf16* proj, const float* Gt, const bf16* ST, const float* nst, const float* gh, bf16* YA, int nblk, int bx, int tid, int lane, int wave) {
    LAS unsigned char* qs = lds; LAS unsigned char* ksm = lds + 17408; LAS unsigned char* vT = lds + 34816; LAS unsigned char* Ap = lds + 71680;
    LAS float* bcs = (LAS float*)(lds + 97280); LAS float* lis = (LAS float*)(lds + 97536); LAS float* rsum = (LAS float*)(lds + 97792); LAS float* denq = (LAS float*)(lds + 98816);
    LAS float* Hs = (LAS float*)lds;
    const int fr = lane & 15, fg = lane >> 4, lp = tid & 31, pcg = tid >> 5;
    const int j2 = tid >> 3, part = tid & 7;
#define M3_LOAD(U, QV, KV, VA, VB, GLF, GLI) do { const int ub_ = (U) >> 10, uh_ = ((U) >> 8) & 3, uc_ = (U) & 255; const size_t ut0_ = (size_t)ub_ * SEQ + (size_t)uc_ * 64; \
        _Pragma("unroll") for (int n = 0; n < 2; ++n) { const int p = tid + 512 * n, row = p >> 4, pc = p & 15; const bf16* rp = proj + (ut0_ + row) * NPROJ + uh_ * 128 + 8 * pc; QV[n] = *(const v4u*)rp; KV[n] = *(const v4u*)(rp + 512); } \
        { const bf16* r0_ = proj + (ut0_ + 2 * lp) * NPROJ; const bf16* r1_ = r0_ + NPROJ; \
          _Pragma("unroll") for (int n = 0; n < 2; ++n) { VA[n] = *(const v4u*)(r0_ + 1024 + uh_ * 256 + 8 * (pcg + 16 * n)); VB[n] = *(const v4u*)(r1_ + 1024 + uh_ * 256 + 8 * (pcg + 16 * n)); } } \
        GLF = Gt[(ut0_ + lane) * 8 + 4 + uh_]; GLI = Gt[(ut0_ + lane) * 8 + uh_]; } while (0)
    v4u nqv[2], nkv[2], nva[2], nvb[2]; float nlf = 0.f, nli = 0.f;
#pragma unroll
    for (int n = 0; n < 2; ++n) { nqv[n] = (v4u){0u, 0u, 0u, 0u}; nkv[n] = nqv[n]; nva[n] = nqv[n]; nvb[n] = nqv[n]; }
    if (bx < 2048) M3_LOAD(bx, nqv, nkv, nva, nvb, nlf, nli);
    for (int unit = bx; unit < 2048; unit += nblk) {
        const int b = unit >> 10, h = (unit >> 8) & 3, c = unit & 255; const size_t t0 = (size_t)b * SEQ + (size_t)c * 64;
        v4u qv[2], kv[2], va[2], vb[2], cf[2][4], ovp[4]; f32x4 nv[4];
#pragma unroll
        for (int n = 0; n < 2; ++n) { qv[n] = nqv[n]; kv[n] = nkv[n]; va[n] = nva[n]; vb[n] = nvb[n]; }
        { const bf16* sp = ST + (size_t)unit * 32768;
#pragma unroll
            for (int et = 0; et < 2; ++et)
#pragma unroll
                for (int k2 = 0; k2 < 4; ++k2) cf[et][k2] = *(const v4u*)(sp + (32 * wave + 16 * et + fr) * 128 + 32 * k2 + 8 * fg); }
#pragma unroll
        for (int i = 0; i < 4; ++i) { ovp[i] = *(const v4u*)(proj + (t0 + j2) * NPROJ + 2048 + h * 256 + 64 * i + 8 * part); nv[i] = *(const f32x4*)(nst + (size_t)unit * 128 + 16 * part + 4 * i); }
        if (wave == 0) {
            const float lf = nlf, li = nli;
            float bs = lf;
#pragma unroll
            for (int o = 1; o < 64; o <<= 1) { const float t = shl_(bs, lane - o); if (lane >= o) bs += t; }
            bcs[lane] = bs; lis[lane] = li;
        }
        __syncthreads();
#pragma unroll
        for (int n = 0; n < 2; ++n) { const int p = tid + 512 * n, row = p >> 4, pc = p & 15;
            *(LAS v4u*)(qs + row * QP + pc * 16) = qv[n]; *(LAS v4u*)(ksm + row * QP + pc * 16) = kv[n];
            const float eb = fexp(bcs[row]); v4u e;
#pragma unroll
            for (int w = 0; w < 4; ++w) e[w] = pk2(bflo(qv[n][w]) * eb, bfhi(qv[n][w]) * eb);
            *(LAS v4u*)(Ap + row * APP + 128 + pc * 16) = e; }
#pragma unroll
        for (int n = 0; n < 2; ++n)
#pragma unroll
            for (int i = 0; i < 8; ++i) *(LAS unsigned*)(vT + (8 * (pcg + 16 * n) + i) * VTP + lp * 4) = elem16(va[n], i) | (elem16(vb[n], i) << 16);
        { const int nu = unit + nblk; if (nu < 2048) M3_LOAD(nu, nqv, nkv, nva, nvb, nlf, nli); }
        __syncthreads();
        {
            const int jt = wave >> 1, j = 16 * jt + fr; const float bj = bcs[j];
#pragma unroll
            for (int sti = 0; sti < 2; ++sti) { const int st = 2 * (wave & 1) + sti;
                f32x4 acc = (f32x4){0.f, 0.f, 0.f, 0.f};
#pragma unroll
                for (int ks = 0; ks < 4; ++ks) { const bf16x8 kf = *(const LAS bf16x8*)(ksm + (16 * st + fr) * QP + (32 * ks + 8 * fg) * 2); const bf16x8 qf = *(const LAS bf16x8*)(qs + j * QP + (32 * ks + 8 * fg) * 2); acc = MFMA16(kf, qf, acc); }
                float val[4]; float rs = 0.f;
#pragma unroll
                for (int jj = 0; jj < 4; ++jj) { const int s = 16 * st + 4 * fg + jj; const float wgt = (s <= j) ? fexp(bj - bcs[s] + lis[s]) : 0.f; val[jj] = (s <= j) ? acc[jj] * KSCALE * wgt : 0.f; rs += val[jj]; }
                rs += shx(rs, 16, lane); rs += shx(rs, 32, lane);
                if (fg == 0) rsum[j * 4 + st] = rs;
                v2u w; w.x = pk2(val[0], val[1]); w.y = pk2(val[2], val[3]);
                *(LAS v2u*)(Ap + j * APP + (16 * st + 4 * fg) * 2) = w; }
        }
        {
            const v4u q0 = *(const LAS v4u*)(qs + j2 * QP + part * 32), q1 = *(const LAS v4u*)(qs + j2 * QP + part * 32 + 16);
            float s = 0.f;
#pragma unroll
            for (int w = 0; w < 4; ++w) { s += bflo(q0[w]) * nv[w >> 1][(2 * w) & 3] + bfhi(q0[w]) * nv[w >> 1][(2 * w + 1) & 3]; s += bflo(q1[w]) * nv[2 + (w >> 1)][(2 * w) & 3] + bfhi(q1[w]) * nv[2 + (w >> 1)][(2 * w + 1) & 3]; }
            s += shx(s, 1, lane); s += shx(s, 2, lane); s += shx(s, 4, lane);
            if (part == 0) denq[j2] = fexp(bcs[j2]) * s;
        }
        __syncthreads();
        f32x4 acc2[2][4];
#pragma unroll
        for (int et = 0; et < 2; ++et)
#pragma unroll
            for (int jt = 0; jt < 4; ++jt) acc2[et][jt] = (f32x4){0.f, 0.f, 0.f, 0.f};
#pragma unroll
        for (int ks = 0; ks < 6; ++ks) {
            bf16x8 af[2];
#pragma unroll
            for (int et = 0; et < 2; ++et) af[et] = (ks < 2) ? *(const LAS bf16x8*)(vT + (32 * wave + 16 * et + fr) * VTP + (32 * ks + 8 * fg) * 2) : __builtin_bit_cast(bf16x8, cf[et][(ks < 2) ? 0 : ks - 2]);
#pragma unroll
            for (int jt = 0; jt < 4; ++jt) { const bf16x8 bq = *(const LAS bf16x8*)(Ap + (16 * jt + fr) * APP + (32 * ks + 8 * fg) * 2);
#pragma unroll
                for (int et = 0; et < 2; ++et) acc2[et][jt] = MFMA16(af[et], bq, acc2[et][jt]); }
        }
        __syncthreads();
#pragma unroll
        for (int et = 0; et < 2; ++et)
#pragma unroll
            for (int jt = 0; jt < 4; ++jt) *(LAS f32x4*)(Hs + (16 * jt + fr) * HSP + 32 * wave + 16 * et + 4 * fg) = acc2[et][jt];
        __syncthreads();
        {
            const float den = (rsum[j2 * 4] + rsum[j2 * 4 + 1]) + (rsum[j2 * 4 + 2] + rsum[j2 * 4 + 3]) + denq[j2];
            const float inv = 1.f / fmaxf(fabsf(den), 1.f);
            float hv[4][8]; float ss = 0.f;
#pragma unroll
            for (int i = 0; i < 4; ++i) {
                const f32x4 h0 = *(const LAS f32x4*)(Hs + j2 * HSP + 64 * i + 8 * part) * inv, h1 = *(const LAS f32x4*)(Hs + j2 * HSP + 64 * i + 8 * part + 4) * inv;
                hv[i][0] = h0.x; hv[i][1] = h0.y; hv[i][2] = h0.z; hv[i][3] = h0.w; hv[i][4] = h1.x; hv[i][5] = h1.y; hv[i][6] = h1.z; hv[i][7] = h1.w;
#pragma unroll
                for (int u = 0; u < 8; ++u) ss += hv[i][u] * hv[i][u]; }
            ss += shx(ss, 1, lane); ss += shx(ss, 2, lane); ss += shx(ss, 4, lane);
            const float r = rsqrtf(ss * (1.f / 256.f) + EPS);
#pragma unroll
            for (int i = 0; i < 4; ++i) { const int e = 64 * i + 8 * part;
                const v4u ov = ovp[i];
                const f32x4 g0 = *(const f32x4*)(gh + h * 256 + e), g1 = *(const f32x4*)(gh + h * 256 + e + 4);
                const float gg[8] = {g0.x, g0.y, g0.z, g0.w, g1.x, g1.y, g1.z, g1.w};
                v4u o;
#pragma unroll
                for (int w = 0; w < 4; ++w) { const float x0 = hv[i][2 * w] * r * gg[2 * w], x1 = hv[i][2 * w + 1] * r * gg[2 * w + 1];
                    const float o0 = bflo(ov[w]), o1 = bfhi(ov[w]);
                    o[w] = pk2(x0 / (1.f + fexp(-o0)), x1 / (1.f + fexp(-o1))); }
                *(v4u*)(YA + (t0 + j2) * DM + h * 256 + e) = o; }
        }
        __syncthreads();
    }
}

#define XB_TMO      128
#define XB_XCNT(j)  (256  + 64 * (j))
#define XB_XSUB(j)  (1280 + 64 * (j))
#define XB_XGEN(j)  (2304 + 64 * (j))
#define XB_TOP      3328
#define XB_TOPGEN   3392
#define XCD_BAR_WORDS 3456
#define XB_SPIN_CAP (1u << 18)

__device__ __forceinline__ unsigned xb_ld(unsigned* p)              { return __hip_atomic_load(p, __ATOMIC_RELAXED, __HIP_MEMORY_SCOPE_AGENT); }
__device__ __forceinline__ unsigned xb_add(unsigned* p, unsigned v) { return __hip_atomic_fetch_add(p, v, __ATOMIC_RELAXED, __HIP_MEMORY_SCOPE_AGENT); }
__device__ __forceinline__ unsigned xb_xcc_id() { return (unsigned)__builtin_amdgcn_s_getreg((3 << 11) | 20) & 0xFu; }
#define XB_SPIN(cond, bar) do { unsigned _sp = 0; while (cond) { __builtin_amdgcn_s_sleep(1); \
    if ((++_sp & 255u) == 0u) { if (xb_ld(&(bar)[XB_TMO])) break; if (_sp > XB_SPIN_CAP) { atomicAdd(&(bar)[XB_TMO], 1u); break; } } } } while (0)

struct XcdBarrier {
    unsigned* bar; unsigned x;
    volatile LAS unsigned* st;
};

__device__ __forceinline__ XcdBarrier xcd_barrier_post(unsigned* bar, volatile LAS unsigned* st) {
    XcdBarrier b; b.bar = bar; b.x = xb_xcc_id(); b.st = st;
    if (threadIdx.x == 0) (void)xb_add(&bar[XB_XCNT(b.x)], 1u);
    return b;
}
__device__ __forceinline__ void xcd_barrier_complete(unsigned* bar, unsigned x, unsigned& nloc, unsigned& nx) {
    const unsigned G = gridDim.x * gridDim.y * gridDim.z;
    unsigned sum, cnt, mine, sp = 0u;
    for (;;) {
        sum = 0u; cnt = 0u; mine = 0u;
#pragma unroll
        for (unsigned j = 0; j < 16; ++j) { const unsigned c = xb_ld(&bar[XB_XCNT(j)]); sum += c; cnt += (c > 0u) ? 1u : 0u; mine = (j == x) ? c : mine; }
        if (sum == G) break;
        __builtin_amdgcn_s_sleep(1);
        if ((++sp & 255u) == 0u) { if (xb_ld(&bar[XB_TMO])) break; if (sp > XB_SPIN_CAP) { atomicAdd(&bar[XB_TMO], 1u); break; } }
    }
    nloc = mine > 0u ? mine : 1u; nx = cnt > 0u ? cnt : 1u;
}

__device__ __forceinline__ void xcd_barrier(const XcdBarrier& b) {
    asm volatile("s_waitcnt vmcnt(0)" ::: "memory");
    __syncthreads();
    if (threadIdx.x == 0) {
        unsigned* bar = b.bar; asm volatile("" : "+s"(bar));
        __builtin_amdgcn_s_waitcnt(0);
        unsigned nloc = b.st[0], nx = b.st[1];
        if (nloc == 0u) { xcd_barrier_complete(bar, b.x, nloc, nx); b.st[0] = nloc; b.st[1] = nx; }
        const unsigned old = xb_add(&bar[XB_XSUB(b.x)], 1u);
        const unsigned gen = old / nloc;
        if (old + 1u == (gen + 1u) * nloc) {
            __builtin_amdgcn_fence(__ATOMIC_RELEASE, "agent");
            asm volatile("s_waitcnt vmcnt(0)" ::: "memory");
            const unsigned og = xb_add(&bar[XB_TOP], 1u);
            const unsigned tg = og / nx;
            if (og + 1u == (tg + 1u) * nx) xb_add(&bar[XB_TOPGEN], 1u);
            else XB_SPIN(xb_ld(&bar[XB_TOPGEN]) == tg, bar);
            __builtin_amdgcn_fence(__ATOMIC_ACQUIRE, "agent");
            xb_add(&bar[XB_XGEN(b.x)], 1u);
            asm volatile("s_waitcnt vmcnt(0)" ::: "memory");
        } else {
            XB_SPIN(xb_ld(&bar[XB_XGEN(b.x)]) == gen, bar);
            __builtin_amdgcn_fence(__ATOMIC_ACQUIRE, "agent");
            asm volatile("s_waitcnt vmcnt(0)" ::: "memory");
        }
    }
    __syncthreads();
}

__global__ void __launch_bounds__(NTHR, 2) mk_fwd(Args a) {
    extern __shared__ __attribute__((aligned(16))) unsigned char lds_raw[];
    LAS unsigned char* lds = (LAS unsigned char*)lds_raw;
    const int ph_lo = __builtin_amdgcn_readfirstlane(a.ph_lo_), ph_hi = __builtin_amdgcn_readfirstlane(a.ph_hi_);
    for (int u = threadIdx.x; u < 16; u += NTHR) ((LAS unsigned*)(lds + LDS_BYTES - 64))[u] = 0u;
    __syncthreads();
    XcdBarrier xbar; xbar.bar = (unsigned*)a.ws + CW_BAR; xbar.x = xb_xcc_id(); xbar.st = (volatile LAS unsigned*)(lds + LDS_BYTES - 64);
    if (ph_hi - ph_lo > 1 && blockIdx.x == 0) { unsigned* bw = (unsigned*)a.ws + CW_BAR; for (int i = threadIdx.x; i < XCD_BAR_WORDS; i += NTHR) __hip_atomic_store(bw + i, 0u, __ATOMIC_RELAXED, __HIP_MEMORY_SCOPE_AGENT); }
    const int nblk = gridDim.x, NGW = nblk * NWAVES, nthr = nblk * NTHR;
    unsigned char* ws = a.ws;
    bf16* XN = (bf16*)(ws + WS_XN); bf16* PROJ = (bf16*)(ws + WS_PROJ); bf16* STb = (bf16*)(ws + WS_ST); bf16* YA = (bf16*)(ws + WS_YA);
    bf16* Qb = (bf16*)(ws + WS_Q); bf16* Kb = (bf16*)(ws + WS_K); bf16* Vb = (bf16*)(ws + WS_V); bf16* Ob = (bf16*)(ws + WS_O); bf16* Hb = (bf16*)(ws + WS_H);
    float* ROPE = (float*)(ws + WS_ROPE); float* Gt = (float*)(ws + WS_G); float* DEC = (float*)(ws + WS_DEC); float* NST = (float*)(ws + WS_NST);
    for (int ph = ph_lo; ph < ph_hi; ++ph) {
        if (ph > ph_lo) { if (ph == ph_lo + 1) { cg::this_grid().sync(); if (threadIdx.x == 0) (void)xb_add(&xbar.bar[XB_XCNT(xbar.x)], 1u); }   else xcd_barrier(xbar); }
        if (ph > 18 && (ph - 19) % 7 == 1) {
            int bxa = blockIdx.x; asm volatile("" : "+s"(bxa));
            const attn_body::AttnTensors AT{(const attn_body::bf16*)Qb, (const attn_body::bf16*)Kb, (const attn_body::bf16*)Vb, (attn_body::bf16*)Ob};
#ifndef NO_ATTN
            const int Lb = (ph - 19) / 7;
            const float* lam = a.b_lam + (size_t)Lb * 256; int tq = threadIdx.x; asm volatile("" : "+v"(tq)); const int ln = tq & 63;
            const float s01 = wave_sum(lam[ln] * lam[64 + ln], ln), s23 = wave_sum(lam[128 + ln] * lam[192 + ln], ln);
            const float lamf = __int_as_float(__builtin_amdgcn_readfirstlane(__float_as_int(fexp(s01) - fexp(s23) + a.lam_init[Lb])));
            const attn_body::Comb CB{(attn_body::bf16*)YA, a.b_g_head + (size_t)Lb * DM, lamf, a.lam_init[Lb]};
            attn_body::attn_phase<8>((char*)lds_raw, AT, CB, nblk, bxa);
#endif
            continue;
        }
        int tid_o = threadIdx.x, bx_o = blockIdx.x; asm volatile("" : "+v"(tid_o)); asm volatile("" : "+s"(bx_o));
        const int tid = tid_o, bx = bx_o, lane = tid & 63, wave = __builtin_amdgcn_readfirstlane(tid >> 6), gw = bx * NWAVES + wave, gtid = bx * NTHR + tid;
        if (ph == 0) {
            conv_weights(a, 0, lds, gw, NGW, wave, lane);
            rope_table(a.pos, ROPE, gtid, nthr);
            __syncthreads();
            NormJob J{a.x, nullptr, nullptr, nullptr, a.norm_g, XN, nullptr, nullptr, a.a_w_in + NPROJ, a.a_b_gates, Gt};
            norm_phase(J, lds, gw, NGW, tid, lane);
            continue;
        }
        int L, sub;
        if (ph <= 18) { L = (ph - 1) / 9; sub = (ph - 1) % 9; } else { const int q = ph - 19, sb = q % 7; L = 2 + q / 7; sub = sb + (sb >= 2 ? 2 : sb); }
        const bool isA = L < 2;
        if (sub == 0 || sub == 4 || sub == 6 || sub == 7) {
            const int ng = (sub == 0 && L == 2) ? 2 : 1;
            for (int gi = 0; gi < ng; ++gi) {
                pg8::Gemm g; pg8::EpiBf16 E; E.act = 0; E.split_cols = 0; E.split_stride = 0; E.scale0 = 1.f; E.rope = nullptr; E.rope_cols = 0;
                if (sub == 0) {
                    if (isA) { g = pg8::Gemm{XN, (const bf16*)(ws + WS_WA), TT, NPROJ, DM}; E.O = PROJ; E.ldc = NPROJ; }
                    else if (gi == 0) { g = pg8::Gemm{XN, (const bf16*)(ws + WS_WA), TT, DM, DM}; E.O = Qb; E.ldc = DM; E.split_cols = DM; E.scale0 = attn_body::C2; E.rope = ROPE; E.rope_cols = DM; }
                    else { g = pg8::Gemm{YA, (const bf16*)(ws + WS_WA) + (size_t)DM * DM, TT, 2 * DM, DM}; E.O = Kb; E.ldc = DM; E.split_cols = DM; E.split_stride = (WS_V - WS_K) / 2; E.rope = ROPE; E.rope_cols = DM; }
                } else if (sub == 4) { g = pg8::Gemm{YA, (const bf16*)(ws + WS_WO), TT, DM, DM}; E.O = XN; E.ldc = DM; }
                else if (sub == 6) { g = pg8::Gemm{XN, (const bf16*)(ws + WS_WU), TT, FF, DM}; E.O = Hb; E.ldc = FF; E.act = 2; }
                else { g = pg8::Gemm{Hb, (const bf16*)(ws + WS_WD), TT, DM, FF}; E.O = XN; E.ldc = DM; }
                pg8::StaticOrder S; S.init(g.M, g.N, nblk, bx);
#ifndef NO_GEMM
                for (int rp = 0; rp < PROBE_GEMM; ++rp) pg8::gemm_phase<pg8::EpiBf16, pg8::StaticOrder, true, true>(lds, g, S, E);
#endif
            }
        } else if (sub == 5 || sub == 8) {
            NormJob J{(L == 0 && sub == 5) ? a.x : a.out, a.out, XN, a.norm_g + (size_t)(L * 4 + (sub == 5 ? 1 : 3)) * DM, nullptr, XN, nullptr, nullptr, nullptr, nullptr, Gt};
            if (sub == 5) J.gpre = a.norm_g + (size_t)(L * 4 + 2) * DM;
            else if (L < 3) {
                conv_weights(a, L + 1, lds, gw, NGW, wave, lane);
                __syncthreads();
                J.gpre = a.norm_g + (size_t)((L + 1) * 4) * DM;
                if (L + 1 < 2) { J.wg = a.a_w_in + (size_t)(L + 1) * DM * MPROJ + NPROJ; J.bg = a.a_b_gates + (L + 1) * 8; }
                if (L + 1 == 2) { J.gkv = a.kv_norm_g; J.XKV = YA; }
            }
            norm_phase(J, lds, gw, NGW, tid, lane);
        } else if (isA) {
#ifndef NO_M
            if (sub == 1) for (int rp = 0; rp < PROBE_M; ++rp) m1_phase(lds, PROJ, Gt, STb, DEC, NST, nblk, bx, tid, lane, wave);
            else if (sub == 2) m2_phase(STb, DEC, NST, gtid, nthr);
            else for (int rp = 0; rp < PROBE_M; ++rp) m3_phase(lds, PROJ, Gt, STb, NST, a.a_g_head + (size_t)L * DM, YA, nblk, bx, tid, lane, wave);
#endif
        } else {
        }
    }
}

extern "C" void kernel_launch(void* const* d_in, const int* in_sizes, int n_in, void* d_out, int out_size, void* d_ws, size_t ws_size, hipStream_t stream) {
    static int grid = 0;
    if (grid == 0) {
        if (n_in != 15 || in_sizes[0] != TT * DM || out_size != TT * DM || ws_size < WS_END) { fprintf(stderr, "kernel_launch: unexpected shapes / workspace (n_in %d, in0 %d, out %d, ws %zu); nothing launched\n", n_in, n_in > 0 ? in_sizes[0] : -1, out_size, ws_size); grid = -1; return; }
        int dev = 0, cus = 0, per_cu = 0;
        if (hipGetDevice(&dev) != hipSuccess || hipDeviceGetAttribute(&cus, hipDeviceAttributeMultiprocessorCount, dev) != hipSuccess) { grid = -1; return; }
        if (hipFuncSetAttribute((const void*)mk_fwd, hipFuncAttributeMaxDynamicSharedMemorySize, LDS_BYTES) != hipSuccess) { fprintf(stderr, "kernel_launch: hipFuncSetAttribute failed\n"); grid = -1; return; }
        if (hipOccupancyMaxActiveBlocksPerMultiprocessor(&per_cu, (const void*)mk_fwd, NTHR, LDS_BYTES) != hipSuccess || per_cu < 1) per_cu = 1;
        (void)hipGetLastError();
        grid = cus * per_cu;
    }
    if (grid < 0) return;
    Args a{};
    a.x = (const float*)d_in[0]; a.pos = (const int*)d_in[1]; a.norm_g = (const float*)d_in[2]; a.a_w_in = (const float*)d_in[3]; a.a_b_gates = (const float*)d_in[4];
    a.a_g_head = (const float*)d_in[5]; a.a_w_out = (const float*)d_in[6]; a.kv_norm_g = (const float*)d_in[7]; a.w_kv = (const float*)d_in[8]; a.b_w_q = (const float*)d_in[9];
    a.b_lam = (const float*)d_in[10]; a.b_g_head = (const float*)d_in[11]; a.b_w_out = (const float*)d_in[12]; a.mlp_up = (const float*)d_in[13]; a.mlp_down = (const float*)d_in[14];
    a.out = (float*)d_out; a.ws = (unsigned char*)d_ws;
    a.lam_init[0] = (float)(0.8 - 0.6 * exp(-0.3 * 2.0)); a.lam_init[1] = (float)(0.8 - 0.6 * exp(-0.3 * 3.0));
#if MK_MULTI
    for (int ph = 0; ph < NPH; ++ph) { a.ph_lo_ = ph; a.ph_hi_ = ph + 1; hipLaunchKernelGGL(mk_fwd, dim3(grid), dim3(NTHR), LDS_BYTES, stream, a); }
#else
    a.ph_lo_ = 0; a.ph_hi_ = NPH;
    void* args[] = {&a};
    hipError_t e = hipLaunchCooperativeKernel((const void*)mk_fwd, dim3(grid), dim3(NTHR), args, LDS_BYTES, stream);
    if (e != hipSuccess) fprintf(stderr, "cooperative launch failed: %s (grid %d)\n", hipGetErrorString(e), grid);
#endif
}
```

```cpp
#include <hip/hip_runtime.h>
#include <hip/hip_cooperative_groups.h>
#include <cstdio>
#include <cstdint>
#include <cmath>
namespace pg8 {
#define PG8_LAS __attribute__((address_space(3)))
typedef unsigned short bf16_t;
typedef short bf16x8 __attribute__((ext_vector_type(8)));
typedef float f32x4 __attribute__((ext_vector_type(4)));
typedef unsigned u32x4 __attribute__((ext_vector_type(4)));
constexpr int BM = 256, BK = 64, HALF = 128, HTB = HALF * BK * 2  , STAGE_BYTES = 8 * HTB, NXCD = 8, WGM = 8;

__host__ __device__ __forceinline__ int lds_byte(int r, int c) { const int st = (r >> 4) * 2 + (c >> 5), rr = r & 15, cc = c & 31, ob = rr * 64 + cc * 2; return st * 1024 + (ob ^ (((ob >> 9) & 1) << 5)); }
__host__ __device__ __forceinline__ void stage_rc(int b, int& R, int& C) { const int st = b / 1024, sb = b % 1024, swz = sb ^ (((sb >> 9) & 1) << 5); R = (st >> 1) * 16 + swz / 64; C = (st & 1) * 32 + (swz % 64) / 2; }
__host__ __device__ __forceinline__ int perm32(int rho) { const int n = rho >> 4, i = rho & 15; return 8 * (i >> 2) + 4 * n + (i & 3); }

struct Unit { int pm, pn; };
struct Gemm { const bf16_t* A; const bf16_t* Bt; int M, N, K; };

struct StaticOrder {
    int nM, nN, nwg, G, c;
    __host__ __device__ void init(int M, int N, int G_, int c_) { nM = M / BM; nN = N / BM; nwg = nM * nN; G = G_; c = c_; }
    __host__ __device__ bool next(int i, Unit& u) const {
        const long L = (long)i * G + c; if (L >= nwg) return false;
        int wgid = (int)L; { const int q = nwg / NXCD, r = nwg % NXCD, xcd = wgid % NXCD, off = wgid / NXCD; wgid = (xcd < r ? xcd * (q + 1) : r * (q + 1) + (xcd - r) * q) + off; }
        const int nig = WGM * nN, gid = wgid / nig, fm = gid * WGM, gsz = (nM - fm) < WGM ? (nM - fm) : WGM;
        u.pm = fm + ((wgid % nig) % gsz); u.pn = (wgid % nig) / gsz; return true;
    }
    __device__ __forceinline__ void a_ready(const Unit&) const {}
    __device__ __forceinline__ void done(const Unit&) const {}
};

__device__ __forceinline__ unsigned cvt_pk_bf16(float lo, float hi) { unsigned r; asm volatile("v_cvt_pk_bf16_f32 %0, %1, %2" : "=v"(r) : "v"(lo), "v"(hi)); return r; }
typedef float f32x2 __attribute__((ext_vector_type(2)));
struct EpiBf16 {
    static constexpr bool PERM = true, AFTER_DRAIN = false;
    bf16_t* O; int ldc; int act; int split_cols; size_t split_stride; float scale0; const float* rope; int rope_cols;
    __device__ __forceinline__ void operator()(const f32x4 (&acc)[2][2][4][2], const Unit& u, int wr, int wc, int fr, int fq) const {
        const int row0 = u.pm * BM + wr * 64 + fr; int colt = u.pn * BM; bf16_t* base = O;
        float sc = 1.f; if (split_cols) { const int t = colt / split_cols; base += (size_t)t * split_stride; colt -= t * split_cols; if (t == 0) sc = scale0; }
        const int col0 = colt + wc * 32 + 8 * fq;
        if (rope != nullptr && u.pn * BM < rope_cols) {
            typedef unsigned u32x2 __attribute__((ext_vector_type(2)));
#pragma unroll
            for (int ai = 0; ai < 2; ++ai)
#pragma unroll
                for (int m = 0; m < 4; ++m) { const size_t row = (size_t)(row0 + ai * HALF + m * 16);
#pragma unroll
                    for (int bj = 0; bj < 2; ++bj) { const int gc = col0 + bj * HALF, hd6 = gc & ~63, m4 = ((gc & 63) >> 3) * 4;
                        const float* tp = rope + row * 64 + m4; const f32x4 cs = *(const f32x4*)tp, sn = *(const f32x4*)(tp + 32);
                        const f32x4 v0 = acc[ai][bj][m][0], v1 = acc[ai][bj][m][1];
                        const f32x4 o1 = (v0 * cs - v1 * sn) * sc, o2 = (v1 * cs + v0 * sn) * sc;
                        u32x2 w1, w2; w1.x = cvt_pk_bf16(o1[0], o1[1]); w1.y = cvt_pk_bf16(o1[2], o1[3]); w2.x = cvt_pk_bf16(o2[0], o2[1]); w2.y = cvt_pk_bf16(o2[2], o2[3]);
                        bf16_t* rp = base + row * ldc + hd6 + m4; *(u32x2*)rp = w1; *(u32x2*)(rp + 32) = w2; } }
            return;
        }
#pragma unroll
        for (int ai = 0; ai < 2; ++ai)
#pragma unroll
            for (int m = 0; m < 4; ++m) { bf16_t* rowp = base + (size_t)(row0 + ai * HALF + m * 16) * ldc + col0;
#pragma unroll
                for (int bj = 0; bj < 2; ++bj) { f32x4 v0 = acc[ai][bj][m][0], v1 = acc[ai][bj][m][1];
                    if (act == 2) {
#pragma unroll
                        for (int e = 0; e < 4; ++e) { const float a0 = fmaxf(v0[e], 0.f), a1 = fmaxf(v1[e], 0.f); v0[e] = a0 * a0; v1[e] = a1 * a1; } }
                    v0 = v0 * sc; v1 = v1 * sc; u32x4 w; w.x = cvt_pk_bf16(v0[0], v0[1]); w.y = cvt_pk_bf16(v0[2], v0[3]); w.z = cvt_pk_bf16(v1[0], v1[1]); w.w = cvt_pk_bf16(v1[2], v1[3]);
                    *(u32x4*)(rowp + bj * HALF) = w; } }
    }
};

template <class Epi, class Sched, bool ALIGN_EPI = false, bool SP2 = false>
__device__ __forceinline__ void gemm_phase(PG8_LAS unsigned char* lds, const Gemm g, const Sched& S, const Epi& E) {
    int tid_o = threadIdx.x; asm volatile("" : "+v"(tid_o));
    const int tid = tid_o, wid = __builtin_amdgcn_readfirstlane(tid >> 6), lane = tid & 63, wr = wid >> 2, wc = wid & 3, fr = lane & 15, fq = lane >> 4;
    const int K = g.K, nt = K / BK;
    unsigned voffA[2], voffB[2];
#pragma unroll
    for (int i = 0; i < 2; ++i) { int R, C; stage_rc(tid * 16 + i * 8192, R, C); const int Rb = Epi::PERM ? ((R & ~31) + perm32(R & 31)) : R;
        voffA[i] = (unsigned)(R * K + C) * 2u; voffB[i] = (unsigned)(Rb * K + C) * 2u; }
    const size_t kstep = (size_t)(BK * 2);
    const size_t hstep = (size_t)HALF * K * 2;
    const size_t tstep = 2 * hstep;
    const unsigned ldsw = (unsigned)wid * 1024u;
    const int aoff = lds_byte(wr * 64 + fr, fq * 8), boff = lds_byte(wc * 32 + fr, fq * 8);
#define PG8_SA(b, h) (((b) * 2 + (h)) * HTB)
#define PG8_SB(b, h) ((4 + (b) * 2 + (h)) * HTB)
#define PG8_STAGE(bufoff, gbase, voff) do { _Pragma("unroll") for (int _i = 0; _i < 2; ++_i) \
        __builtin_amdgcn_global_load_lds((const unsigned*)((const char*)(gbase) + (voff)[_i]), (PG8_LAS unsigned*)(lds + (bufoff) + ldsw + _i * 8192), 16, 0, 0); } while (0)
#define PG8_LDA(dst, b, h) do { _Pragma("unroll") for (int m = 0; m < 4; ++m) _Pragma("unroll") for (int k = 0; k < 2; ++k) dst[m][k] = *(const PG8_LAS bf16x8*)(lds + PG8_SA(b, h) + aoff + m * 2048 + k * 1024); } while (0)
#define PG8_LDB(dst, b, h) do { _Pragma("unroll") for (int n = 0; n < 2; ++n) _Pragma("unroll") for (int k = 0; k < 2; ++k) dst[n][k] = *(const PG8_LAS bf16x8*)(lds + PG8_SB(b, h) + boff + n * 2048 + k * 1024); } while (0)
#define PG8_MMA(ai, bj, At, Bt) do { __builtin_amdgcn_s_setprio(1); _Pragma("unroll") for (int m = 0; m < 4; ++m) _Pragma("unroll") for (int n = 0; n < 2; ++n) _Pragma("unroll") for (int k = 0; k < 2; ++k) \
        acc[ai][bj][m][n] = __builtin_amdgcn_mfma_f32_16x16x32_bf16(Bt[n][k], At[m][k], acc[ai][bj][m][n], 0, 0, 0); __builtin_amdgcn_s_setprio(0); } while (0)
#define PG8_WAIT_V(n) asm volatile("s_waitcnt vmcnt(" #n ")" ::: "memory")
#define PG8_WAIT_L(n) asm volatile("s_waitcnt lgkmcnt(" #n ")" ::: "memory")
#define PG8_BAR __builtin_amdgcn_s_barrier()
#define PG8_SCHED __builtin_amdgcn_sched_barrier(0)
    Unit cur, nxt; int ui = 0;
    if (!S.next(0, cur)) return;
    f32x4 acc[2][2][4][2];
#pragma unroll
    for (int a = 0; a < 2; ++a)
#pragma unroll
        for (int b = 0; b < 2; ++b)
#pragma unroll
            for (int m = 0; m < 4; ++m)
#pragma unroll
                for (int n = 0; n < 2; ++n) acc[a][b][m][n] = (f32x4){0.f, 0.f, 0.f, 0.f};
    bf16x8 At[4][2], B0[2][2], B1[2][2];
    const char* cA = (const char*)g.A + (size_t)cur.pm * tstep; const char* cB = (const char*)g.Bt + (size_t)cur.pn * tstep;
    S.a_ready(cur);
    if constexpr (SP2) {
        PG8_STAGE(PG8_SB(0, 0), cB, voffB); PG8_STAGE(PG8_SB(0, 1), cB + hstep, voffB); PG8_STAGE(PG8_SA(0, 0), cA, voffA); PG8_STAGE(PG8_SA(0, 1), cA + hstep, voffA);
        if (wr == 1) PG8_BAR;
        PG8_WAIT_V(2); PG8_BAR;
        PG8_STAGE(PG8_SB(1, 0), cB + kstep, voffB); PG8_STAGE(PG8_SA(1, 0), cA + kstep, voffA); PG8_STAGE(PG8_SB(1, 1), cB + hstep + kstep, voffB);
        PG8_WAIT_V(6); PG8_BAR;
    } else {
        PG8_STAGE(PG8_SB(0, 0), cB, voffB); PG8_STAGE(PG8_SA(0, 0), cA, voffA); PG8_STAGE(PG8_SB(0, 1), cB + hstep, voffB); PG8_STAGE(PG8_SA(0, 1), cA + hstep, voffA);
        if (wr == 1) PG8_BAR;
        PG8_WAIT_V(4); PG8_BAR;
        PG8_STAGE(PG8_SB(1, 0), cB + kstep, voffB); PG8_STAGE(PG8_SA(1, 0), cA + kstep, voffA); PG8_STAGE(PG8_SB(1, 1), cB + hstep + kstep, voffB);
        PG8_WAIT_V(6); PG8_BAR;
    }
    for (;;) {
        const bool has_next = S.next(ui + 1, nxt);
        const char* nA = has_next ? (const char*)g.A + (size_t)nxt.pm * tstep : cA; const char* nB = has_next ? (const char*)g.Bt + (size_t)nxt.pn * tstep : cB;
        for (int t = 0; t < nt; t += 2) {
            const bool last = (t == nt - 2);
            const char* a1 = cA + (size_t)(t + 1) * kstep;
            const char* a2 = last ? nA : cA + (size_t)(t + 2) * kstep; const char* b2 = last ? nB : cB + (size_t)(t + 2) * kstep;
            const char* a3 = a2 + kstep; const char* b3 = b2 + kstep;
            if (last && has_next) S.a_ready(nxt);
            if constexpr (SP2) {
            PG8_LDB(B0, 0, 0); PG8_LDB(B1, 0, 1); PG8_SCHED; PG8_LDA(At, 0, 0); PG8_STAGE(PG8_SA(1, 1), a1 + hstep, voffA);
            PG8_WAIT_V(8); PG8_WAIT_L(0); PG8_BAR; PG8_MMA(0, 0, At, B0); PG8_MMA(0, 1, At, B1); PG8_BAR; PG8_SCHED;
            PG8_LDA(At, 0, 1); PG8_STAGE(PG8_SB(0, 0), b2, voffB); PG8_STAGE(PG8_SB(0, 1), b2 + hstep, voffB); PG8_STAGE(PG8_SA(0, 0), a2, voffA);
            PG8_WAIT_V(8); PG8_WAIT_L(0); PG8_BAR; PG8_MMA(1, 0, At, B0); PG8_MMA(1, 1, At, B1); PG8_BAR; PG8_SCHED;
            PG8_LDB(B0, 1, 0); PG8_LDB(B1, 1, 1); PG8_SCHED; PG8_LDA(At, 1, 0); PG8_STAGE(PG8_SA(0, 1), a2 + hstep, voffA);
            PG8_WAIT_V(8); PG8_WAIT_L(0); PG8_BAR; PG8_MMA(0, 0, At, B0); PG8_MMA(0, 1, At, B1); PG8_BAR; PG8_SCHED;
            PG8_LDA(At, 1, 1); PG8_STAGE(PG8_SB(1, 0), b3, voffB); PG8_STAGE(PG8_SB(1, 1), b3 + hstep, voffB); PG8_STAGE(PG8_SA(1, 0), a3, voffA);
            PG8_WAIT_V(8); PG8_WAIT_L(0); PG8_BAR; PG8_MMA(1, 0, At, B0); PG8_MMA(1, 1, At, B1); PG8_BAR; PG8_SCHED;
            } else {
            PG8_LDB(B0, 0, 0); PG8_SCHED; PG8_LDA(At, 0, 0); PG8_STAGE(PG8_SA(1, 1), a1 + hstep, voffA);
            PG8_WAIT_L(8); PG8_BAR; PG8_WAIT_L(0); PG8_MMA(0, 0, At, B0); PG8_BAR; PG8_SCHED;
            PG8_LDB(B1, 0, 1); PG8_STAGE(PG8_SB(0, 0), b2, voffB);
            PG8_BAR; PG8_WAIT_L(0); PG8_MMA(0, 1, At, B1); PG8_BAR;
            PG8_LDA(At, 0, 1); PG8_STAGE(PG8_SA(0, 0), a2, voffA);
            PG8_BAR; PG8_WAIT_L(0); PG8_MMA(1, 0, At, B0); PG8_BAR; PG8_SCHED;
            PG8_STAGE(PG8_SB(0, 1), b2 + hstep, voffB);
            PG8_WAIT_V(6); PG8_BAR; PG8_MMA(1, 1, At, B1); PG8_BAR;
            PG8_LDB(B0, 1, 0); PG8_SCHED; PG8_LDA(At, 1, 0); PG8_STAGE(PG8_SA(0, 1), a2 + hstep, voffA);
            PG8_WAIT_L(8); PG8_BAR; PG8_WAIT_L(0); PG8_MMA(0, 0, At, B0); PG8_BAR; PG8_SCHED;
            PG8_LDB(B1, 1, 1); PG8_STAGE(PG8_SB(1, 0), b3, voffB);
            PG8_BAR; PG8_WAIT_L(0); PG8_MMA(0, 1, At, B1); PG8_BAR;
            PG8_LDA(At, 1, 1); PG8_STAGE(PG8_SA(1, 0), a3, voffA);
            PG8_BAR; PG8_WAIT_L(0); PG8_MMA(1, 0, At, B0); PG8_BAR; PG8_SCHED;
            PG8_STAGE(PG8_SB(1, 1), b3 + hstep, voffB);
            PG8_WAIT_V(6); PG8_BAR; PG8_MMA(1, 1, At, B1); PG8_BAR;
            }
        }
        if constexpr (ALIGN_EPI) { if (wr == 0) PG8_BAR; }
        if constexpr (!Epi::AFTER_DRAIN) { E(acc, cur, wr, wc, fr, fq); S.done(cur); }
        if (!has_next) break;
#pragma unroll
        for (int a = 0; a < 2; ++a)
#pragma unroll
            for (int b = 0; b < 2; ++b)
#pragma unroll
                for (int m = 0; m < 4; ++m)
#pragma unroll
                    for (int n = 0; n < 2; ++n) acc[a][b][m][n] = (f32x4){0.f, 0.f, 0.f, 0.f};
        cur = nxt; cA = nA; cB = nB; ++ui;
        if constexpr (ALIGN_EPI) { if (wr == 1) PG8_BAR; }
    }
    PG8_WAIT_V(0);
    if constexpr (!ALIGN_EPI) { if (wr == 0) PG8_BAR; }
    PG8_BAR;
    if constexpr (Epi::AFTER_DRAIN) { E.fused(acc, cur, wr, wc, fr, fq, lds, wid, lane); S.done(cur); }
#undef PG8_SA
#undef PG8_SB
#undef PG8_STAGE
#undef PG8_LDA
#undef PG8_LDB
#undef PG8_MMA
#undef PG8_WAIT_V
#undef PG8_WAIT_L
#undef PG8_BAR
#undef PG8_SCHED
}
}

#include <hip/hip_bf16.h>
#include <cmath>
namespace attn_body {
using bf16=__hip_bfloat16;
using bf16x8=__attribute__((ext_vector_type(8)))short;
using s16x4=__attribute__((ext_vector_type(4)))short;
using f32x16=__attribute__((ext_vector_type(16)))float;
using u32x4=__attribute__((ext_vector_type(4)))unsigned;
constexpr int BATCH=2,NHEAD=16,SEQ=16384,D=64,DM=NHEAD*D,OPITCH=2048;
constexpr int NW=8,QBLK=32,QB=QBLK*NW,KVBLK=64,NQB=SEQ/QB;
constexpr int ATTN_PITCH=DM, ATTN_UNIT_ROWS=QB;
__device__ __forceinline__ int crow(int r,int hi){return (r&3)+8*(r>>2)+4*hi;}
#define SBAR() __builtin_amdgcn_sched_barrier(0)
__device__ __forceinline__ void cmask(f32x16&p0,f32x16&p1,int jb,int qrel,int hi){
  const float NEG=-INFINITY; int kb=64*jb+4*hi;
  #pragma unroll
  for(int r=0;r<16;++r){int kv=kb+(r&3)+8*(r>>2); if(kv>qrel)p0[r]=NEG; if(kv+32>qrel)p1[r]=NEG;}
}

constexpr int NSLOT=3, SLOTB=8192;
constexpr int LDS_K=0, LDS_V=NSLOT*SLOTB, LDS_V2=2*NSLOT*SLOTB, LDS_WS=3*NSLOT*SLOTB, LDS_OST=LDS_WS+NW*64*4, LDS_BYTES=LDS_OST+NW*8192;
constexpr float C2=0.125f*1.4426950408889634f;
__device__ __forceinline__ void glds16(const void*gsrc,unsigned lds_dst){unsigned keep;
  asm volatile("s_mov_b32 %0, m0\n\ts_mov_b32 m0, %2\n\ts_nop 0\n\tglobal_load_lds_dwordx4 %1, off\n\ts_mov_b32 m0, %0":"=&s"(keep):"v"(gsrc),"s"(lds_dst):"memory");}
__device__ __forceinline__ float max3f(float a,float b,float c){float r;asm("v_max3_f32 %0, %1, %2, %3":"=v"(r):"v"(a),"v"(b),"v"(c));return r;}
__device__ __forceinline__ float max2f(float a,float b){float r;asm("v_max_f32_e32 %0, %1, %2":"=v"(r):"v"(a),"v"(b));return r;}
__device__ __forceinline__ float fadd_s(float a,float b){float r;asm("v_add_f32_e32 %0, %1, %2":"=v"(r):"v"(a),"v"(b));return r;}
__device__ __forceinline__ float fsub_s(float a,float b){float r;asm("v_sub_f32_e32 %0, %1, %2":"=v"(r):"v"(a),"v"(b));return r;}
typedef float f32x2_t __attribute__((ext_vector_type(2))); typedef __bf16 bf16x2_t __attribute__((ext_vector_type(2)));
__device__ __forceinline__ unsigned cvtpk_s(float lo,float hi){f32x2_t v={lo,hi};bf16x2_t b=__builtin_convertvector(v,bf16x2_t);return __builtin_bit_cast(unsigned,b);}
#define WAIT_BAR(N) asm volatile("s_waitcnt vmcnt(" #N ") lgkmcnt(0)\n\ts_barrier":::"memory")

__device__ __forceinline__ void qkt(f32x16&p0,f32x16&p1,const char*Kslot,const bf16x8*qr,const f32x16&negm,int r32,int hi){
  const char*kb=Kslot+hi*1024+r32*16;
  #pragma unroll
  for(int d0=0;d0<4;++d0){
    const bf16x8 b0=*reinterpret_cast<const bf16x8*>(kb+d0*2048);
    const bf16x8 b1=*reinterpret_cast<const bf16x8*>(kb+d0*2048+512);
    if(d0==0){p0=__builtin_amdgcn_mfma_f32_32x32x16_bf16(b0,qr[0],negm,0,0,0);p1=__builtin_amdgcn_mfma_f32_32x32x16_bf16(b1,qr[0],negm,0,0,0);}
    else{p0=__builtin_amdgcn_mfma_f32_32x32x16_bf16(b0,qr[d0],p0,0,0,0);p1=__builtin_amdgcn_mfma_f32_32x32x16_bf16(b1,qr[d0],p1,0,0,0);}}
}
typedef __attribute__((address_space(3))) const char* lds_cptr;
typedef short v4i16_t __attribute__((ext_vector_type(4)));
__device__ __forceinline__ void kload8(bf16x8*kf,lds_cptr kp){
  kf[0]=*(const __attribute__((address_space(3))) bf16x8*)(kp);      kf[1]=*(const __attribute__((address_space(3))) bf16x8*)(kp+512);
  kf[2]=*(const __attribute__((address_space(3))) bf16x8*)(kp+2048); kf[3]=*(const __attribute__((address_space(3))) bf16x8*)(kp+2560);
  kf[4]=*(const __attribute__((address_space(3))) bf16x8*)(kp+4096); kf[5]=*(const __attribute__((address_space(3))) bf16x8*)(kp+4608);
  kf[6]=*(const __attribute__((address_space(3))) bf16x8*)(kp+6144); kf[7]=*(const __attribute__((address_space(3))) bf16x8*)(kp+6656);
}
__device__ __forceinline__ void kload2(bf16x8*kf,lds_cptr kp,int j){ kf[2*j]=*(const __attribute__((address_space(3))) bf16x8*)(kp+j*2048); kf[2*j+1]=*(const __attribute__((address_space(3))) bf16x8*)(kp+j*2048+512); }
__device__ __forceinline__ s16x4 vtr(lds_cptr p){ return __builtin_bit_cast(s16x4,__builtin_amdgcn_ds_read_tr16_b64_v4i16((__attribute__((address_space(3))) v4i16_t*)p)); }
__device__ __forceinline__ float rowmax(const f32x16&p0,const f32x16&p1){
  float a=max3f(p0[0],p0[1],p1[0]),b=max3f(p0[2],p0[3],p1[1]);a=max3f(a,p1[2],p1[3]);
  #pragma unroll
  for(int r=4;r<16;r+=4){a=max3f(a,p0[r],p0[r+1]);b=max3f(b,p0[r+2],p0[r+3]);a=max3f(a,p1[r],p1[r+1]);b=max3f(b,p1[r+2],p1[r+3]);}
  const float m=max2f(a,b);
  auto rr=__builtin_amdgcn_permlane32_swap(__float_as_uint(m),__float_as_uint(m),false,false);
  return max2f(__uint_as_float(rr[0]),__uint_as_float(rr[1]));
}
__device__ __forceinline__ void pv(f32x16*o,int vb,bf16x8 pa0,bf16x8 pa1,bf16x8 pa2,bf16x8 pa3){
  #pragma unroll
  for(int d0=0;d0<2;++d0){s16x4 lo[4],hi[4];
    #pragma unroll
    for(int ks=0;ks<4;++ks){
      asm volatile("ds_read_b64_tr_b16 %0,%1 offset:%c2":"=&v"(lo[ks]):"v"(vb),"i"(d0*4096+ks*1024):"memory");
      asm volatile("ds_read_b64_tr_b16 %0,%1 offset:%c2":"=&v"(hi[ks]):"v"(vb),"i"(d0*4096+ks*1024+512):"memory");}
    asm volatile("s_waitcnt lgkmcnt(0)":::"memory");SBAR();
    #define PK(k) (bf16x8){lo[k][0],lo[k][1],lo[k][2],lo[k][3],hi[k][0],hi[k][1],hi[k][2],hi[k][3]}
    o[d0]=__builtin_amdgcn_mfma_f32_32x32x16_bf16(pa0,PK(0),o[d0],0,0,0);
    o[d0]=__builtin_amdgcn_mfma_f32_32x32x16_bf16(pa1,PK(1),o[d0],0,0,0);
    o[d0]=__builtin_amdgcn_mfma_f32_32x32x16_bf16(pa2,PK(2),o[d0],0,0,0);
    o[d0]=__builtin_amdgcn_mfma_f32_32x32x16_bf16(pa3,PK(3),o[d0],0,0,0);
    #undef PK
  }
}

#ifndef ATTN_STORE16
#define ATTN_STORE16(p,v) (*(u32x4*)(p)=(v))
#endif
struct Comb { bf16* XA; const float* gh; float lamf, lam_init; };
template<int THRL> __device__ __forceinline__ void attn_unit(int b,int qcol,int vcol,int ocol,int qb,const bf16*Q,const bf16*__restrict__ K,const bf16*__restrict__ V,bf16*O,char*shm,bool comb,const Comb&CB){
  int tid_o=threadIdx.x; asm volatile("":"+v"(tid_o)); const int tid=tid_o,lane=tid&63,r32=lane&31,hi=lane>>5; const int wid=__builtin_amdgcn_readfirstlane(tid>>6);
  const long rowbase=(long)b*SEQ; const int q0=qb*QB;
  const bf16*Qw=Q+(rowbase+q0+wid*QBLK)*DM+qcol;
  const bf16*Kh=K+rowbase*DM+qcol,*Vh=V+rowbase*DM+vcol;
  const unsigned lds0=(unsigned)(uintptr_t)shm;
  float*wsf=(float*)(shm+LDS_WS)+wid*64;
  const bf16*ksrc=Kh+(long)lane*DM+wid*8;
  const bf16*vsrc=Vh+(long)(16*(wid&3)+(lane>>2))*DM+(wid>>2)*32+(lane&3)*8;
  const unsigned kdst=lds0+LDS_K+wid*1024, vdst=lds0+LDS_V+wid*1024;
  #define DMA_K(t,slot) glds16(ksrc+(long)(t)*KVBLK*DM,(unsigned)__builtin_amdgcn_readfirstlane(kdst+(slot)))
  #define DMA_V(t,slot) do{ glds16(vsrc+(long)(t)*KVBLK*DM,(unsigned)__builtin_amdgcn_readfirstlane(vdst+(slot))); glds16(vsrc+64+(long)(t)*KVBLK*DM,(unsigned)__builtin_amdgcn_readfirstlane(vdst+(LDS_V2-LDS_V)+(slot))); }while(0)
  const int vb0=(int)(lds0+LDS_V)+((lane>>4)&1)*32+(lane&3)*8+(4*hi+((lane&15)>>2))*64;
  const char*Kbase=shm+LDS_K; bf16x8 kf[8];
  const lds_cptr shm3=(lds_cptr)shm; const lds_cptr kp0=shm3+LDS_K+hi*1024+r32*16; const lds_cptr vp0=shm3+LDS_V+((lane>>4)&1)*32+(lane&3)*8+(4*hi+((lane&15)>>2))*64;
  const int NT=(q0+QB)/KVBLK;
  DMA_K(0,0);DMA_V(0,0);DMA_K(1,SLOTB);
  bf16x8 qr[4];
  #pragma unroll
  for(int d0=0;d0<4;++d0)qr[d0]=*reinterpret_cast<const bf16x8*>(&Qw[(long)r32*DM+d0*16+hi*8]);
  __attribute__((address_space(3))) char*qst=(__attribute__((address_space(3))) char*)(shm3+LDS_OST+wid*8192+lane*16);
  #pragma unroll
  for(int d0=0;d0<4;++d0)*(__attribute__((address_space(3))) bf16x8*)(qst+d0*1024)=qr[d0];
  #define QRD(k) (*(const __attribute__((address_space(3))) bf16x8*)(qst+(k)*1024))
  float mhat=0.f,l_reg=0.f;f32x16 o[4];o[0]=f32x16{};o[1]=f32x16{};o[2]=f32x16{};o[3]=f32x16{};f32x16 negm=f32x16{};asm volatile("":"+v"(negm));
  const int qrel=wid*QBLK+r32;
  #define CMASK(P0,P1,t) do{int jb_=(t)-(NT-4); if(jb_>=0)cmask(P0,P1,jb_,qrel,hi);}while(0)
  bool resc=false;
  #define START(P0,P1) do{ const float rm=rowmax(P0,P1); resc=false; \
    { const float dl=rm; mhat=fadd_s(mhat,dl); \
      _Pragma("unroll") for(int r=0;r<16;++r){P0[r]=fsub_s(P0[r],dl);P1[r]=fsub_s(P1[r],dl);} \
      _Pragma("unroll") for(int r=0;r<16;++r)negm[r]=-mhat; asm volatile("":"+v"(negm)); } \
    _Pragma("unroll") for(int r=0;r<16;++r)P0[r]=__builtin_amdgcn_exp2f(P0[r]); }while(0)
  #define RESC() do{ if(resc){ asm volatile("s_waitcnt lgkmcnt(0)":::"memory"); \
      _Pragma("unroll") for(int d_=0;d_<4;++d_) _Pragma("unroll") for(int r=0;r<16;++r)o[d_][r]*=wsf[crow(r,hi)]; } }while(0)
  f32x16 pA0,pA1,pB0,pB1;
  int sl_prev=0,sl_cur=0,sl_next=SLOTB;
  #define ROT() do{sl_prev=sl_cur;sl_cur=sl_next;sl_next=(sl_next==(NSLOT-1)*SLOTB)?0:sl_next+SLOTB;}while(0)
  DMA_K(2,2*SLOTB);
  WAIT_BAR(3);
  qkt(pA0,pA1,Kbase,qr,negm,r32,hi);asm volatile("s_nop 15\n\ts_nop 7":"+v"(pA0),"+v"(pA1));CMASK(pA0,pA1,0);
  START(pA0,pA1);
  _Pragma("unroll") for(int r=0;r<16;++r)pA1[r]=__builtin_amdgcn_exp2f(pA1[r]);
  WAIT_BAR(0);
  DMA_K(3,0);DMA_V(1,SLOTB);
  ROT();
  kload8(kf,kp0+sl_cur);
  WAIT_BAR(3);
  s16x4 vlo[8],vhi[8]; u32x4 pw0,pw1,pw2,pw3;
  #define PKW(P,B) cvtpk_s(P[B],P[B+1])
  #define PAF(k) __builtin_bit_cast(bf16x8,pw##k)
  typedef float f32x4_t __attribute__((ext_vector_type(4)));
  #define PAFS(P,b) __builtin_bit_cast(bf16x8,(f32x4_t){P[b],P[(b)+1],P[(b)+2],P[(b)+3]})
  float dummy_pin=0.f;
  #define VFR(i) (bf16x8){vlo[i][0],vlo[i][1],vlo[i][2],vlo[i][3],vhi[i][0],vhi[i][1],vhi[i][2],vhi[i][3]}
  #define PIN(x) asm volatile("":"+v"(x))
  #define MX3(a,b,c) __builtin_fmaxf(__builtin_fmaxf((a),(b)),(c))
  #define GAPA(MF,A0,A1,A2,A3,W0,W1,PW) do{ MF; sacc+=(f32x2_t){A0,A1}; sacc+=(f32x2_t){A2,A3}; PIN(sacc); W0; W1; PIN(PW); SBAR(); }while(0)
  #define EX(v) __builtin_amdgcn_exp2f(v)
  #define GAPB(MF,X,B) do{ MF; X[B]=EX(X[B]); X[B+1]=EX(X[B+1]); X[B+2]=EX(X[B+2]); X[B+3]=EX(X[B+3]); PIN(X); SBAR(); }while(0)
  #define GAPB2(MF,X,B) do{ MF; X[B]=EX(X[B]); X[B+1]=EX(X[B+1]); PIN(X); SBAR(); }while(0)
  #define VRD(i) do{ vlo[i]=vtr(vp_+(((i)>>2)*4096+((i)&3)*1024)); vhi[i]=vtr(vp_+(((i)>>2)*4096+((i)&3)*1024+512)); }while(0)
  #define VRD2(i) do{ vlo[i]=vtr(vp_+((LDS_V2-LDS_V)+((i)>>2)*4096+((i)&3)*1024)); vhi[i]=vtr(vp_+((LDS_V2-LDS_V)+((i)>>2)*4096+((i)&3)*1024+512)); SBAR(); }while(0)
  #define KRD(G,j) do{ if(G){ kload2(kf,kp0+sl_next,j); SBAR(); } }while(0)
  #define STEP(C0,C1,P0,P1,t,GK,GV,GL) do{ SBAR(); \
    const lds_cptr vp_=vp0+sl_prev; \
    VRD(0); SBAR(); f32x2_t sacc={P0[0],P0[1]}; \
    GAPA(C0=__builtin_amdgcn_mfma_f32_32x32x16_bf16(kf[0],qr[0],negm,0,0,0), P0[2],P0[3],P0[4],P0[5],     P0[0]=__uint_as_float(PKW(P0,0)), P0[1]=__uint_as_float(PKW(P0,2)), dummy_pin); \
    VRD(4); SBAR(); GAPA(C1=__builtin_amdgcn_mfma_f32_32x32x16_bf16(kf[1],qr[0],negm,0,0,0), P0[6],P0[7],P0[8],P0[9],     P0[2]=__uint_as_float(PKW(P0,4)), P0[3]=__uint_as_float(PKW(P0,6)), dummy_pin); \
    VRD(1); SBAR(); const bf16x8 qq1_=QRD(1); GAPA(C0=__builtin_amdgcn_mfma_f32_32x32x16_bf16(kf[2],qq1_,C0,0,0,0),   P0[10],P0[11],P0[12],P0[13], P0[4]=__uint_as_float(PKW(P0,8)), P0[5]=__uint_as_float(PKW(P0,10)), dummy_pin); \
    VRD(5); SBAR(); GAPA(C1=__builtin_amdgcn_mfma_f32_32x32x16_bf16(kf[3],qq1_,C1,0,0,0),   P0[14],P0[15],P1[0],P1[1],   P0[6]=__uint_as_float(PKW(P0,12)), P0[7]=__uint_as_float(PKW(P0,14)), dummy_pin); \
    VRD(2); SBAR(); const bf16x8 qq2_=QRD(2); GAPA(C0=__builtin_amdgcn_mfma_f32_32x32x16_bf16(kf[4],qq2_,C0,0,0,0),   P1[2],P1[3],P1[4],P1[5],     P1[0]=__uint_as_float(PKW(P1,0)), P1[1]=__uint_as_float(PKW(P1,2)), dummy_pin); \
    VRD(6); SBAR(); GAPA(C1=__builtin_amdgcn_mfma_f32_32x32x16_bf16(kf[5],qq2_,C1,0,0,0),   P1[6],P1[7],P1[8],P1[9],     P1[2]=__uint_as_float(PKW(P1,4)), P1[3]=__uint_as_float(PKW(P1,6)), dummy_pin); \
    VRD(3); SBAR(); const bf16x8 qq3_=QRD(3); GAPA(C0=__builtin_amdgcn_mfma_f32_32x32x16_bf16(kf[6],qq3_,C0,0,0,0),   P1[10],P1[11],P1[12],P1[13], P1[4]=__uint_as_float(PKW(P1,8)), P1[5]=__uint_as_float(PKW(P1,10)), dummy_pin); \
    VRD(7); SBAR(); GAPA(C1=__builtin_amdgcn_mfma_f32_32x32x16_bf16(kf[7],qq3_,C1,0,0,0),   P1[14],P1[15],0.f,0.f,       P1[6]=__uint_as_float(PKW(P1,12)), P1[7]=__uint_as_float(PKW(P1,14)), dummy_pin); \
    l_reg+=sacc.x+sacc.y; \
    if(GK){DMA_K((t)+3,sl_cur);} if(GV){DMA_V((t)+1,sl_next);} \
    CMASK(C0,C1,t); \
    { float a=MX3(C0[0],C0[1],C1[0]),b=MX3(C0[2],C0[3],C1[1]); a=MX3(a,C1[2],C1[3]); \
      _Pragma("unroll") for(int r=4;r<16;r+=4){a=MX3(a,C0[r],C0[r+1]);b=MX3(b,C0[r+2],C0[r+3]);a=MX3(a,C1[r],C1[r+1]);b=MX3(b,C1[r+2],C1[r+3]);} \
      float rm=__builtin_fmaxf(a,b); { auto rr=__builtin_amdgcn_permlane32_swap(__float_as_uint(rm),__float_as_uint(rm),false,false); rm=__builtin_fmaxf(__uint_as_float(rr[0]),__uint_as_float(rr[1])); } \
      resc=false; \
      if(__builtin_expect(__any(rm>(float)THRL),0)){ const float dl=__builtin_fmaxf(rm,0.f); mhat+=dl; \
        _Pragma("unroll") for(int r=0;r<16;++r){C0[r]-=dl;C1[r]-=dl;} \
        _Pragma("unroll") for(int r=0;r<16;++r)negm[r]=-mhat; asm volatile("":"+v"(negm)); \
        const float f=__builtin_amdgcn_exp2f(-dl); l_reg*=f; if(hi==0)wsf[r32]=f; resc=true; } } \
    SBAR(); \
    GAPB2(o[0]=__builtin_amdgcn_mfma_f32_32x32x16_bf16(PAFS(P0,0),VFR(0),o[0],0,0,0), C0,0); VRD2(0); \
    GAPB2(o[1]=__builtin_amdgcn_mfma_f32_32x32x16_bf16(PAFS(P0,0),VFR(4),o[1],0,0,0), C0,2); VRD2(4); \
    KRD(GL,0); GAPB2(o[0]=__builtin_amdgcn_mfma_f32_32x32x16_bf16(PAFS(P0,4),VFR(1),o[0],0,0,0), C0,4); VRD2(1); \
    KRD(GL,1); GAPB2(o[1]=__builtin_amdgcn_mfma_f32_32x32x16_bf16(PAFS(P0,4),VFR(5),o[1],0,0,0), C0,6); VRD2(5); \
    KRD(GL,2); GAPB2(o[0]=__builtin_amdgcn_mfma_f32_32x32x16_bf16(PAFS(P1,0),VFR(2),o[0],0,0,0), C0,8); VRD2(2); \
    KRD(GL,3); GAPB2(o[1]=__builtin_amdgcn_mfma_f32_32x32x16_bf16(PAFS(P1,0),VFR(6),o[1],0,0,0), C0,10); VRD2(6); \
    GAPB2(o[0]=__builtin_amdgcn_mfma_f32_32x32x16_bf16(PAFS(P1,4),VFR(3),o[0],0,0,0), C0,12); VRD2(3); \
    GAPB2(o[1]=__builtin_amdgcn_mfma_f32_32x32x16_bf16(PAFS(P1,4),VFR(7),o[1],0,0,0), C0,14); VRD2(7); \
    GAPB2(o[2]=__builtin_amdgcn_mfma_f32_32x32x16_bf16(PAFS(P0,0),VFR(0),o[2],0,0,0), C1,0); \
    GAPB2(o[3]=__builtin_amdgcn_mfma_f32_32x32x16_bf16(PAFS(P0,0),VFR(4),o[3],0,0,0), C1,2); \
    GAPB2(o[2]=__builtin_amdgcn_mfma_f32_32x32x16_bf16(PAFS(P0,4),VFR(1),o[2],0,0,0), C1,4); \
    GAPB2(o[3]=__builtin_amdgcn_mfma_f32_32x32x16_bf16(PAFS(P0,4),VFR(5),o[3],0,0,0), C1,6); \
    GAPB2(o[2]=__builtin_amdgcn_mfma_f32_32x32x16_bf16(PAFS(P1,0),VFR(2),o[2],0,0,0), C1,8); \
    GAPB2(o[3]=__builtin_amdgcn_mfma_f32_32x32x16_bf16(PAFS(P1,0),VFR(6),o[3],0,0,0), C1,10); \
    GAPB2(o[2]=__builtin_amdgcn_mfma_f32_32x32x16_bf16(PAFS(P1,4),VFR(3),o[2],0,0,0), C1,12); \
    GAPB2(o[3]=__builtin_amdgcn_mfma_f32_32x32x16_bf16(PAFS(P1,4),VFR(7),o[3],0,0,0), C1,14); \
    }while(0)
  int t=1;
  #undef CMASK
  #define CMASK(P0,P1,t) do{}while(0)
  for(;t+5<NT;t+=2){
    STEP(pB0,pB1,pA0,pA1,t,true,true,true);     WAIT_BAR(3); RESC(); ROT();
    STEP(pA0,pA1,pB0,pB1,t+1,true,true,true);   WAIT_BAR(3); RESC(); ROT();
  }
  #undef CMASK
  #define CMASK(P0,P1,t) do{int jb_=(t)-(NT-4); if(jb_>=0)cmask(P0,P1,jb_,qrel,hi);}while(0)
  #define ENDW(tt) do{ if((tt)+3<NT){WAIT_BAR(3);} else if((tt)+2<NT){WAIT_BAR(2);} else {WAIT_BAR(0);} }while(0)
  for(;t+1<NT;t+=2){
    STEP(pB0,pB1,pA0,pA1,t,(t+3<NT),(t+1<NT),(t+1<NT));       ENDW(t);   RESC(); ROT();
    STEP(pA0,pA1,pB0,pB1,t+1,(t+4<NT),(t+2<NT),(t+2<NT));     ENDW(t+1); RESC(); ROT();
  }
  STEP(pB0,pB1,pA0,pA1,NT-1,false,false,false); RESC();
  { float sacc=pB0[0]+pB0[1]; _Pragma("unroll") for(int r=2;r<16;++r)sacc+=pB0[r]; _Pragma("unroll") for(int r=0;r<16;++r)sacc+=pB1[r]; l_reg+=sacc;
    pw0=(u32x4){PKW(pB0,0),PKW(pB0,2),PKW(pB0,4),PKW(pB0,6)};pw1=(u32x4){PKW(pB0,8),PKW(pB0,10),PKW(pB0,12),PKW(pB0,14)};pw2=(u32x4){PKW(pB1,0),PKW(pB1,2),PKW(pB1,4),PKW(pB1,6)};pw3=(u32x4){PKW(pB1,8),PKW(pB1,10),PKW(pB1,12),PKW(pB1,14)};
    SBAR(); pv(o,vb0+sl_cur,PAF(0),PAF(1),PAF(2),PAF(3)); pv(o+2,vb0+(LDS_V2-LDS_V)+sl_cur,PAF(0),PAF(1),PAF(2),PAF(3)); }
  #undef PKW
  #undef PAF
  #undef PAFS
  #undef VFR
  #undef PIN
  #undef MX3
  #undef GAPA
  #undef GAPB
  #undef GAPB2
  #undef EX
  #undef VRD
  #undef VRD2
  #undef QRD
  #undef KRD
  #undef STEP
  #undef ENDW
  {auto rr=__builtin_amdgcn_permlane32_swap(__float_as_uint(l_reg),__float_as_uint(l_reg),false,false);l_reg=__uint_as_float(rr[0])+__uint_as_float(rr[1]);}
  if(hi==0)wsf[32+r32]=l_reg;asm volatile("s_waitcnt lgkmcnt(0)":::"memory");
  float rli[16];
  #pragma unroll
  for(int r=0;r<16;++r)rli[r]=__builtin_amdgcn_rcpf(wsf[32+crow(r,hi)]);
  bf16*Ow=O+(rowbase+q0+wid*QBLK)*OPITCH+ocol;
  { bf16*stg=(bf16*)(shm+LDS_OST)+wid*4096;
    #pragma unroll
    for(int r=0;r<16;++r){const int orow=crow(r,hi);
      #pragma unroll
      for(int d0=0;d0<4;++d0)stg[orow*128+d0*32+r32]=__float2bfloat16(o[d0][r]*rli[r]);}
    asm volatile("s_waitcnt lgkmcnt(0)":::"memory");
    if(!comb){
      #pragma unroll
      for(int i=0;i<8;++i){const int row=i*4+(lane>>4),ch=lane&15; const u32x4 v=*(const u32x4*)(stg+row*128+ch*8); ATTN_STORE16(Ow+(long)row*OPITCH+ch*8,v);}
    } else {
      const int hcol=(ocol>>8)*128; const float post=1.f-CB.lam_init;
      #pragma unroll
      for(int i=0;i<8;++i){const int row=i*4+(lane>>4),ch=lane&15;
        const u32x4 v1=*(const u32x4*)(stg+row*128+ch*8); const u32x4 v0=*(const u32x4*)(Ow-128+(long)row*OPITCH+ch*8);
        float d[8]; float ss=0.f;
        #pragma unroll
        for(int w=0;w<4;++w){ d[2*w]=__uint_as_float(v0[w]<<16)-CB.lamf*__uint_as_float(v1[w]<<16); d[2*w+1]=__uint_as_float(v0[w]&0xffff0000u)-CB.lamf*__uint_as_float(v1[w]&0xffff0000u); ss+=d[2*w]*d[2*w]+d[2*w+1]*d[2*w+1]; }
        _Pragma("unroll") for(int sx=1;sx<16;sx<<=1) ss+=__int_as_float(__builtin_amdgcn_ds_bpermute((lane^sx)<<2,__float_as_int(ss)));
        const float rn=rsqrtf(ss*(1.f/128.f)+1e-6f)*post;
        const float*gp=CB.gh+hcol+ch*8; const float4 g0=*(const float4*)gp,g1=*(const float4*)(gp+4);
        u32x4 ov; ov[0]=cvtpk_s(d[0]*rn*g0.x,d[1]*rn*g0.y); ov[1]=cvtpk_s(d[2]*rn*g0.z,d[3]*rn*g0.w); ov[2]=cvtpk_s(d[4]*rn*g1.x,d[5]*rn*g1.y); ov[3]=cvtpk_s(d[6]*rn*g1.z,d[7]*rn*g1.w);
        *(u32x4*)(CB.XA+(rowbase+q0+wid*QBLK+row)*DM+hcol+ch*8)=ov; }
    } }
  asm volatile("s_waitcnt lgkmcnt(0)\n\ts_barrier":::"memory");
  #undef DMA_K
  #undef DMA_V
  #undef CMASK
  #undef START
  #undef RESC
  #undef ROT
}
constexpr int ATTN_LDS_BYTES=LDS_BYTES;
struct AttnTensors { const bf16* Q; const bf16* K; const bf16* V; bf16* O; };
template<int THRL=8> __device__ __forceinline__ void attn_phase(char*lds,const AttnTensors&T,const Comb&CB,int grid,int block){
  const bool fast=(grid==256);
  for(int i=0;;++i){
    int bh,j;
    if(fast){ if(i>=8)break; bh=(i>>2)*8+(block&7); j=block>>3; }
    else { const long p=(long)(i>>2)*grid+block; if(p>=16*32)break; bh=(int)(p>>5); j=(int)(p&31); }
    const int c=i&1, qb=(i&2)?(NQB-1-j):j, b=bh>>3, vh=(bh&7)*2+c;
    attn_unit<THRL>(b,vh*64,(vh>>1)*128,vh*128,qb,T.Q,T.K,T.V,T.O,lds,c==1,CB);
  }
}
#undef SBAR
#undef WAIT_BAR
}

namespace cg = cooperative_groups;
#define LAS __attribute__((address_space(3)))
typedef unsigned short bf16;
typedef unsigned v4u __attribute__((ext_vector_type(4)));
typedef unsigned v2u __attribute__((ext_vector_type(2)));
typedef float f32x4 __attribute__((ext_vector_type(4)));
typedef short bf16x8 __attribute__((ext_vector_type(8)));
#ifndef PROBE_ATTN
#define PROBE_ATTN 1
#endif
#ifndef PROBE_GEMM
#define PROBE_GEMM 1
#endif
#ifndef PROBE_M
#define PROBE_M 1
#endif
#ifndef MK_MULTI
#define MK_MULTI 0
#endif
constexpr int NWAVES = 8, NTHR = 512;
constexpr int BATCH = 2, SEQ = 16384, DM = 1024, TT = BATCH * SEQ, FF = 4096;
constexpr int MPROJ = 3080, NPROJ = 3072;
constexpr float EPS = 1e-6f;
constexpr float KSCALE = 0.08838834764831845f;
constexpr int NPH = 33;
constexpr size_t MiB = 1u << 20;
constexpr size_t WS_WA = 2 * MiB, WS_WO = 8 * MiB, WS_WU = 10 * MiB, WS_WD = 18 * MiB;
constexpr size_t WS_XN = 32 * MiB;
constexpr size_t WS_K = 96 * MiB, WS_V = 160 * MiB;
constexpr size_t WS_PROJ = 96 * MiB;
constexpr size_t WS_ST = 288 * MiB;
constexpr size_t WS_YA = 416 * MiB;
constexpr size_t WS_Q = 224 * MiB;
constexpr size_t WS_O = 288 * MiB;
constexpr size_t WS_H = 224 * MiB;
constexpr size_t WS_ROPE = 480 * MiB;
constexpr size_t WS_G = 488 * MiB;
constexpr size_t WS_DEC = 489 * MiB;
constexpr size_t WS_NST = 490 * MiB;
constexpr size_t WS_END = 491 * MiB;
constexpr int CW_BAR = 4096;
constexpr size_t CTL_ZERO_BYTES = 65536;
constexpr int LDS_BYTES = 147456;

struct Args {
    const float* x; const int* pos; const float* norm_g; const float* a_w_in; const float* a_b_gates; const float* a_g_head; const float* a_w_out;
    const float* kv_norm_g; const float* w_kv; const float* b_w_q; const float* b_lam; const float* b_g_head; const float* b_w_out;
    const float* mlp_up; const float* mlp_down; float* out; unsigned char* ws;
    float lam_init[2]; int ph_lo_, ph_hi_;
};

__device__ __forceinline__ unsigned f2bf(float f) { unsigned u = __builtin_bit_cast(unsigned, f); return (u + 0x7fffu + ((u >> 16) & 1u)) >> 16; }
__device__ __forceinline__ unsigned pk2(float lo, float hi) { return f2bf(lo) | (f2bf(hi) << 16); }
__device__ __forceinline__ float bflo(unsigned w) { return __uint_as_float(w << 16); }
__device__ __forceinline__ float bfhi(unsigned w) { return __uint_as_float(w & 0xffff0000u); }
__device__ __forceinline__ float shx(float v, int o, int lane) { return __int_as_float(__builtin_amdgcn_ds_bpermute((lane ^ o) << 2, __float_as_int(v))); }
__device__ __forceinline__ float shl_(float v, int src) { return __int_as_float(__builtin_amdgcn_ds_bpermute(src << 2, __float_as_int(v))); }
__device__ __forceinline__ float wave_sum(float v, int lane) {
#pragma unroll
    for (int o = 1; o < 64; o <<= 1) v += shx(v, o, lane);
    return v;
}
__device__ __forceinline__ float fexp(float x) { return __builtin_amdgcn_exp2f(x * 1.4426950408889634f); }
#define MFMA16(a, b, c) __builtin_amdgcn_mfma_f32_16x16x32_bf16((a), (b), (c), 0, 0, 0)

__device__ __forceinline__ int rope_perm(int c) { const int w = c & 63; return (c & ~63) + 8 * ((w & 31) >> 2) + 4 * (w >> 5) + (w & 3); }
__device__ __forceinline__ void transpose_item(const float* W, int K, int ldw, int N, bf16* WT, LAS float* scr, int item, int lane, int perm_lim) {
    const int nblk = N / 32, kb = item / nblk, nb = item % nblk, k0 = 64 * kb, n0 = 32 * nb;
    float wv[32];
#pragma unroll
    for (int i = 0; i < 32; ++i) wv[i] = W[(size_t)(k0 + 2 * i + (lane >> 5)) * ldw + n0 + (lane & 31)];
#pragma unroll
    for (int i = 0; i < 32; ++i) scr[(2 * i + (lane >> 5)) * 33 + (lane & 31)] = wv[i];
    asm volatile("s_waitcnt lgkmcnt(0)" ::: "memory");
    const int c = lane & 7;
#pragma unroll
    for (int j = 0; j < 4; ++j) { const int n = (lane >> 3) + 8 * j; const LAS float* s = scr + (8 * c) * 33 + n;
        v4u o; o.x = pk2(s[0 * 33], s[1 * 33]); o.y = pk2(s[2 * 33], s[3 * 33]); o.z = pk2(s[4 * 33], s[5 * 33]); o.w = pk2(s[6 * 33], s[7 * 33]);
        const int nn = n0 + n, nd = (nn < perm_lim) ? rope_perm(nn) : nn;
        *(v4u*)(WT + (size_t)nd * K + k0 + 8 * c) = o; }
    asm volatile("s_waitcnt lgkmcnt(0)" ::: "memory");
}
__device__ __forceinline__ void conv_weights(const Args& a, int L, LAS unsigned char* lds, int gw, int NGW, int wave, int lane) {
    LAS float* scr = (LAS float*)(lds + wave * 16384);
    unsigned char* ws = a.ws;
    const float* W0; int K0, ld0, N0; const float* W1 = nullptr; int N1 = 0, ld1 = 0;
    const float* Wo;
    if (L < 2) { W0 = a.a_w_in + (size_t)L * DM * MPROJ; K0 = DM; ld0 = MPROJ; N0 = NPROJ; Wo = a.a_w_out + (size_t)L * DM * DM; }
    else { W0 = a.b_w_q + (size_t)(L - 2) * DM * DM; K0 = DM; ld0 = DM; N0 = DM; Wo = a.b_w_out + (size_t)(L - 2) * DM * DM; if (L == 2) { W1 = a.w_kv; N1 = 2 * DM; ld1 = 2 * DM; } }
    const float* Wu = a.mlp_up + (size_t)L * DM * FF; const float* Wd = a.mlp_down + (size_t)L * FF * DM;
    const int I0 = (K0 / 64) * (N0 / 32), I1 = (DM / 64) * (N1 / 32), IO = (DM / 64) * (DM / 32), IU = (DM / 64) * (FF / 32), ID = (FF / 64) * (DM / 32);
    const int NIT = I0 + I1 + IO + IU + ID;
    for (int it = gw; it < NIT; it += NGW) {
        int r = it;
        if (r < I0) { transpose_item(W0, K0, ld0, N0, (bf16*)(ws + WS_WA), scr, r, lane, (L >= 2) ? DM : 0); continue; } r -= I0;
        if (r < I1) { transpose_item(W1, DM, ld1, N1, (bf16*)(ws + WS_WA) + (size_t)DM * DM, scr, r, lane, DM); continue; } r -= I1;
        if (r < IO) { transpose_item(Wo, DM, DM, DM, (bf16*)(ws + WS_WO), scr, r, lane, 0); continue; } r -= IO;
        if (r < IU) { transpose_item(Wu, DM, FF, FF, (bf16*)(ws + WS_WU), scr, r, lane, 0); continue; } r -= IU;
        transpose_item(Wd, FF, DM, DM, (bf16*)(ws + WS_WD), scr, r, lane, 0);
    }
}

__device__ __forceinline__ void rope_table(const int* pos, float* tab, int gtid, int nthr) {
    for (int idx = gtid; idx < TT * 32; idx += nthr) {
        const int t = idx >> 5, i = idx & 31;
        double p = 1.0;
        for (int k = 0; k < i; ++k) p *= 1.333521432163324;
        const float inv = 1.0f / (float)p;
        const float ang = (float)pos[t] * inv;
        const double rev = (double)ang * 0.15915494309189535;
        const double fr = rev - rint(rev);
        const double q = rint(fr * 4.0);
        const float r = (float)((fr - q * 0.25) * 6.283185307179586);
        const float r2 = r * r;
        const float sn = r * (1.f + r2 * (-1.f / 6.f + r2 * (1.f / 120.f + r2 * (-1.f / 5040.f + r2 * (1.f / 362880.f)))));
        const float cs = 1.f + r2 * (-0.5f + r2 * (1.f / 24.f + r2 * (-1.f / 720.f + r2 * (1.f / 40320.f))));
        const int qi = ((int)q) & 3;
        const float c = (qi == 0) ? cs : (qi == 1) ? -sn : (qi == 2) ? -cs : sn;
        const float s = (qi == 0) ? sn : (qi == 1) ? cs : (qi == 2) ? -sn : -cs;
        tab[(size_t)t * 64 + i] = c; tab[(size_t)t * 64 + 32 + i] = s;
    }
}

struct NormJob { const float* xin; float* xout; const bf16* Y; const float* gpost; const float* gpre; bf16* XN; const float* gkv; bf16* XKV; const float* wg; const float* bg; float* G; };
__device__ __forceinline__ float softcap15(float z) { const float e = fexp(fminf(z * (2.f / 15.f), 80.f)); return 15.f * ((e - 1.f) / (e + 1.f)); }
__device__ __forceinline__ void norm_phase(const NormJob& J, LAS unsigned char* lds, int gw, int NGW, int tid, int lane) {
    LAS float* wl = (LAS float*)lds;
    if (J.wg) {
        for (int i = tid; i < 8192; i += NTHR) { const int d = i >> 3, q = i & 7; wl[q * 1024 + d] = J.wg[(size_t)d * MPROJ + q]; }
        __syncthreads();
    }
    constexpr int NR = 2;
    f32x4 nxv[2][NR][4]; v2u nyw[2][NR][4];
#pragma unroll
    for (int d = 0; d < 2; ++d)
#pragma unroll
        for (int r = 0; r < NR; ++r)
#pragma unroll
            for (int j = 0; j < 4; ++j) { nxv[d][r][j] = (f32x4){0.f, 0.f, 0.f, 0.f}; nyw[d][r][j] = (v2u){0u, 0u}; }
#pragma unroll
    for (int d = 0; d < 2; ++d) { const int mf = gw * NR + d * NGW * NR;
        if (mf < TT) {
#pragma unroll
            for (int r = 0; r < NR; ++r)
#pragma unroll
                for (int j = 0; j < 4; ++j) nxv[d][r][j] = __builtin_nontemporal_load((const f32x4*)(J.xin + (size_t)(mf + r) * DM) + lane + 64 * j);
            if (J.Y) {
#pragma unroll
                for (int r = 0; r < NR; ++r)
#pragma unroll
                    for (int j = 0; j < 4; ++j) nyw[d][r][j] = __builtin_nontemporal_load((const v2u*)(J.Y + (size_t)(mf + r) * DM) + lane + 64 * j); }
        } }
    for (int m0 = gw * NR; m0 < TT; m0 += NGW * NR) {
        f32x4 v[NR][4]; v2u yw[NR][4];
#pragma unroll
        for (int r = 0; r < NR; ++r)
#pragma unroll
            for (int j = 0; j < 4; ++j) { v[r][j] = nxv[0][r][j]; yw[r][j] = nyw[0][r][j]; nxv[0][r][j] = nxv[1][r][j]; nyw[0][r][j] = nyw[1][r][j]; }
        { const int m2 = m0 + 2 * NGW * NR;
          if (m2 < TT) {
#pragma unroll
            for (int r = 0; r < NR; ++r)
#pragma unroll
                for (int j = 0; j < 4; ++j) nxv[1][r][j] = __builtin_nontemporal_load((const f32x4*)(J.xin + (size_t)(m2 + r) * DM) + lane + 64 * j);
            if (J.Y) {
#pragma unroll
                for (int r = 0; r < NR; ++r)
#pragma unroll
                    for (int j = 0; j < 4; ++j) nyw[1][r][j] = __builtin_nontemporal_load((const v2u*)(J.Y + (size_t)(m2 + r) * DM) + lane + 64 * j); }
          } }
        if (J.Y) {
            float s[NR];
            f32x4 y[NR][4];
#pragma unroll
            for (int r = 0; r < NR; ++r) { s[r] = 0.f;
#pragma unroll
                for (int j = 0; j < 4; ++j) { const v2u w = yw[r][j]; y[r][j] = (f32x4){bflo(w.x), bfhi(w.x), bflo(w.y), bfhi(w.y)}; s[r] += (y[r][j].x * y[r][j].x + y[r][j].y * y[r][j].y) + (y[r][j].z * y[r][j].z + y[r][j].w * y[r][j].w); } }
#pragma unroll
            for (int o = 1; o < 64; o <<= 1) {
#pragma unroll
                for (int r = 0; r < NR; ++r) s[r] += shx(s[r], o, lane); }
#pragma unroll
            for (int r = 0; r < NR; ++r) { const float rr = rsqrtf(s[r] * (1.f / DM) + EPS);
                f32x4* xo = (f32x4*)(J.xout + (size_t)(m0 + r) * DM) + lane;
#pragma unroll
                for (int j = 0; j < 4; ++j) { const f32x4 gp = ((const f32x4*)J.gpost)[lane + 64 * j]; v[r][j] = v[r][j] + y[r][j] * rr * gp; __builtin_nontemporal_store(v[r][j], xo + 64 * j); } }
        }
        if (J.gpre) {
            float s2[NR];
#pragma unroll
            for (int r = 0; r < NR; ++r) { s2[r] = 0.f;
#pragma unroll
                for (int j = 0; j < 4; ++j) s2[r] += (v[r][j].x * v[r][j].x + v[r][j].y * v[r][j].y) + (v[r][j].z * v[r][j].z + v[r][j].w * v[r][j].w); }
#pragma unroll
            for (int o = 1; o < 64; o <<= 1) {
#pragma unroll
                for (int r = 0; r < NR; ++r) s2[r] += shx(s2[r], o, lane); }
#pragma unroll
            for (int r = 0; r < NR; ++r) { const int m = m0 + r;
                const float r2 = rsqrtf(s2[r] * (1.f / DM) + EPS);
                v2u* xn = (v2u*)(J.XN + (size_t)m * DM) + lane;
                f32x4 hn[4];
#pragma unroll
                for (int j = 0; j < 4; ++j) { const f32x4 g = ((const f32x4*)J.gpre)[lane + 64 * j]; hn[j] = v[r][j] * r2 * g; v2u w; w.x = pk2(hn[j].x, hn[j].y); w.y = pk2(hn[j].z, hn[j].w); xn[64 * j] = w; }
                if (J.gkv) {
                    v2u* xk = (v2u*)(J.XKV + (size_t)m * DM) + lane;
#pragma unroll
                    for (int j = 0; j < 4; ++j) { const f32x4 g = ((const f32x4*)J.gkv)[lane + 64 * j]; const f32x4 hk = v[r][j] * r2 * g; v2u w; w.x = pk2(hk.x, hk.y); w.y = pk2(hk.z, hk.w); xk[64 * j] = w; }
                }
                if (J.wg) {
                    float ga[8];
#pragma unroll
                    for (int q = 0; q < 8; ++q) { float sq = 0.f;
#pragma unroll
                        for (int j = 0; j < 4; ++j) { const f32x4 w = *(const LAS f32x4*)(wl + q * 1024 + 4 * lane + 256 * j); sq += (hn[j].x * w.x + hn[j].y * w.y) + (hn[j].z * w.z + hn[j].w * w.w); }
                        ga[q] = sq; }
#pragma unroll
                    for (int o = 1; o < 64; o <<= 1) {
#pragma unroll
                        for (int q = 0; q < 8; ++q) ga[q] += shx(ga[q], o, lane); }
                    const int q = lane & 7;
                    float z = (q == 0) ? ga[0] : (q == 1) ? ga[1] : (q == 2) ? ga[2] : (q == 3) ? ga[3] : (q == 4) ? ga[4] : (q == 5) ? ga[5] : (q == 6) ? ga[6] : ga[7];
                    z = softcap15(z + J.bg[q]);
                    if (q >= 4) z = fminf(z, 0.f) - __logf(1.f + fexp(-fabsf(z)));
                    if (lane < 8) J.G[(size_t)m * 8 + q] = z;
                }
            }
        }
    }
}

constexpr int VTP = 144;
constexpr int QP = 272;
constexpr int APP = 400;
constexpr int HSP = 260;

__device__ __forceinline__ unsigned elem16(const v4u& v, int i) { return (v[i >> 1] >> (16 * (i & 1))) & 0xffffu; }

__device__ __forceinline__ void m1_phase(LAS unsigned char* lds, const bf16* proj, const float* Gt, bf16* ST, float* dec, float* nst, int nblk, int bx, int tid, int lane, int wave) {
    LAS unsigned char* vT = lds; LAS unsigned char* kT = lds + 36864; LAS float* wsv = (LAS float*)(lds + 55296);
    const int fr = lane & 15, fg = lane >> 4, lp = tid & 31, pcg = tid >> 5;
    for (int unit = bx; unit < 2048; unit += nblk) {
        const int b = unit >> 10, h = (unit >> 8) & 3, c = unit & 255; const size_t t0 = (size_t)b * SEQ + (size_t)c * 64;
        if (wave == 0) {
            const float lf = Gt[(t0 + lane) * 8 + 4 + h], li = Gt[(t0 + lane) * 8 + h];
            float bs = lf;
#pragma unroll
            for (int o = 1; o < 64; o <<= 1) { const float t = shl_(bs, lane - o); if (lane >= o) bs += t; }
            const float bl = shl_(bs, 63);
            wsv[lane] = fexp(bl - bs + li) * KSCALE;
            if (lane == 63) dec[unit] = fexp(bl);
        }
        const bf16* r0 = proj + (t0 + 2 * lp) * NPROJ; const bf16* r1 = r0 + NPROJ;
        v4u va[2], vb[2];
#pragma unroll
        for (int n = 0; n < 2; ++n) { va[n] = *(const v4u*)(r0 + 1024 + h * 256 + 8 * (pcg + 16 * n)); vb[n] = *(const v4u*)(r1 + 1024 + h * 256 + 8 * (pcg + 16 * n)); }
        const v4u ka = *(const v4u*)(r0 + 512 + h * 128 + 8 * pcg), kb = *(const v4u*)(r1 + 512 + h * 128 + 8 * pcg);
        __syncthreads();
#pragma unroll
        for (int n = 0; n < 2; ++n)
#pragma unroll
            for (int i = 0; i < 8; ++i) *(LAS unsigned*)(vT + (8 * (pcg + 16 * n) + i) * VTP + lp * 4) = elem16(va[n], i) | (elem16(vb[n], i) << 16);
        const float w0 = wsv[2 * lp], w1 = wsv[2 * lp + 1];
#pragma unroll
        for (int i = 0; i < 8; ++i) *(LAS unsigned*)(kT + (8 * pcg + i) * VTP + lp * 4) = f2bf(__uint_as_float(elem16(ka, i) << 16) * w0) | (f2bf(__uint_as_float(elem16(kb, i) << 16) * w1) << 16);
        __syncthreads();
        f32x4 acc[2][8];
#pragma unroll
        for (int mt = 0; mt < 2; ++mt)
#pragma unroll
            for (int nt = 0; nt < 8; ++nt) acc[mt][nt] = (f32x4){0.f, 0.f, 0.f, 0.f};
#pragma unroll
        for (int ks = 0; ks < 2; ++ks) {
            bf16x8 vf[2];
#pragma unroll
            for (int mt = 0; mt < 2; ++mt) vf[mt] = *(const LAS bf16x8*)(vT + (32 * wave + 16 * mt + fr) * VTP + (32 * ks + 8 * fg) * 2);
#pragma unroll
            for (int nt = 0; nt < 8; ++nt) { const bf16x8 kf = *(const LAS bf16x8*)(kT + (16 * nt + fr) * VTP + (32 * ks + 8 * fg) * 2);
#pragma unroll
                for (int mt = 0; mt < 2; ++mt) acc[mt][nt] = MFMA16(kf, vf[mt], acc[mt][nt]); }
        }
        bf16* sp = ST + (size_t)unit * 32768;
        {
            LAS unsigned char* stg = lds + 57344 + wave * 8704;
#pragma unroll
            for (int mt = 0; mt < 2; ++mt)
#pragma unroll
                for (int nt = 0; nt < 8; ++nt) { v2u w; w.x = pk2(acc[mt][nt][0], acc[mt][nt][1]); w.y = pk2(acc[mt][nt][2], acc[mt][nt][3]);
                    *(LAS v2u*)(stg + (16 * mt + fr) * 272 + (16 * nt + 4 * fg) * 2) = w; }
#pragma unroll
            for (int i = 0; i < 8; ++i) { const int et = i >> 2, k2 = i & 3;
                const v4u v = *(const LAS v4u*)(stg + (16 * et + fr) * 272 + (32 * k2 + 8 * fg) * 2);
                *(v4u*)(sp + (size_t)((((wave * 2 + et) * 4 + k2) * 64 + lane) * 8)) = v; }
        }
        if (tid < 128) { float s = 0.f;
#pragma unroll
            for (int i = 0; i < 8; ++i) { const v4u w = *(const LAS v4u*)(kT + tid * VTP + i * 16);
#pragma unroll
                for (int e = 0; e < 4; ++e) s += bflo(w[e]) + bfhi(w[e]); }
            nst[(size_t)unit * 128 + tid] = s; }
        __syncthreads();
    }
}

__device__ __forceinline__ void m2_phase(bf16* ST, const float* dec, float* nst, int gtid, int nthr) {
    for (int chain = gtid; chain < 8 * 16384; chain += nthr) {
        const int bh = chain >> 14, idx = chain & 16383;
        unsigned* p = (unsigned*)ST + (size_t)bh * 256 * 16384 + idx; const float* dc = dec + bh * 256;
        float r0 = 0.f, r1 = 0.f;
        for (int c0 = 0; c0 < 256; c0 += 32) {
            unsigned v[32];
#pragma unroll
            for (int i = 0; i < 32; ++i) v[i] = p[(size_t)(c0 + i) * 16384];
#pragma unroll
            for (int i = 0; i < 32; ++i) { const float d = dc[c0 + i]; p[(size_t)(c0 + i) * 16384] = pk2(r0, r1); r0 = d * r0 + bflo(v[i]); r1 = d * r1 + bfhi(v[i]); }
        }
    }
    for (int chain = gtid; chain < 8 * 128; chain += nthr) {
        const int bh = chain >> 7, d = chain & 127;
        float* p = nst + (size_t)bh * 256 * 128 + d; const float* dc = dec + bh * 256;
        float r = 0.f;
        for (int c0 = 0; c0 < 256; c0 += 16) {
            float v[16];
#pragma unroll
            for (int i = 0; i < 16; ++i) v[i] = p[(c0 + i) * 128];
#pragma unroll
            for (int i = 0; i < 16; ++i) { const float dd = dc[c0 + i]; p[(c0 + i) * 128] = r; r = dd * r + v[i]; }
        }
    }
}

__device__ __forceinline__ void m3_phase(LAS unsigned char* lds, const bf16* proj, const float* Gt, const bf16* ST, const float* nst, const float* gh, bf16* YA, int nblk, int bx, int tid, int lane, int wave) {
    LAS unsigned char* qs = lds; LAS unsigned char* ksm = lds + 17408; LAS unsigned char* vT = lds + 34816; LAS unsigned char* Ap = lds + 71680;
    LAS float* bcs = (LAS float*)(lds + 97280); LAS float* lis = (LAS float*)(lds + 97536); LAS float* rsum = (LAS float*)(lds + 97792); LAS float* denq = (LAS float*)(lds + 98816);
    LAS float* Hs = (LAS float*)lds;
    const int fr = lane & 15, fg = lane >> 4, lp = tid & 31, pcg = tid >> 5;
    const int j2 = tid >> 3, part = tid & 7;
#define M3_LOAD(U, QV, KV, VA, VB, GLF, GLI) do { const int ub_ = (U) >> 10, uh_ = ((U) >> 8) & 3, uc_ = (U) & 255; const size_t ut0_ = (size_t)ub_ * SEQ + (size_t)uc_ * 64; \
        _Pragma("unroll") for (int n = 0; n < 2; ++n) { const int p = tid + 512 * n, row = p >> 4, pc = p & 15; const bf16* rp = proj + (ut0_ + row) * NPROJ + uh_ * 128 + 8 * pc; QV[n] = *(const v4u*)rp; KV[n] = *(const v4u*)(rp + 512); } \
        { const bf16* r0_ = proj + (ut0_ + 2 * lp) * NPROJ; const bf16* r1_ = r0_ + NPROJ; \
          _Pragma("unroll") for (int n = 0; n < 2; ++n) { VA[n] = *(const v4u*)(r0_ + 1024 + uh_ * 256 + 8 * (pcg + 16 * n)); VB[n] = *(const v4u*)(r1_ + 1024 + uh_ * 256 + 8 * (pcg + 16 * n)); } } \
        GLF = Gt[(ut0_ + lane) * 8 + 4 + uh_]; GLI = Gt[(ut0_ + lane) * 8 + uh_]; } while (0)
    v4u nqv[2], nkv[2], nva[2], nvb[2]; float nlf = 0.f, nli = 0.f;
#pragma unroll
    for (int n = 0; n < 2; ++n) { nqv[n] = (v4u){0u, 0u, 0u, 0u}; nkv[n] = nqv[n]; nva[n] = nqv[n]; nvb[n] = nqv[n]; }
    if (bx < 2048) M3_LOAD(bx, nqv, nkv, nva, nvb, nlf, nli);
    for (int unit = bx; unit < 2048; unit += nblk) {
        const int b = unit >> 10, h = (unit >> 8) & 3, c = unit & 255; const size_t t0 = (size_t)b * SEQ + (size_t)c * 64;
        v4u qv[2], kv[2], va[2], vb[2], cf[2][4], ovp[4]; f32x4 nv[4];
#pragma unroll
        for (int n = 0; n < 2; ++n) { qv[n] = nqv[n]; kv[n] = nkv[n]; va[n] = nva[n]; vb[n] = nvb[n]; }
        { const bf16* sp = ST + (size_t)unit * 32768;
#pragma unroll
            for (int et = 0; et < 2; ++et)
#pragma unroll
                for (int k2 = 0; k2 < 4; ++k2) cf[et][k2] = *(const v4u*)(sp + (size_t)((((wave * 2 + et) * 4 + k2) * 64 + lane) * 8)); }
#pragma unroll
        for (int i = 0; i < 4; ++i) { ovp[i] = *(const v4u*)(proj + (t0 + j2) * NPROJ + 2048 + h * 256 + 64 * i + 8 * part); nv[i] = *(const f32x4*)(nst + (size_t)unit * 128 + 16 * part + 4 * i); }
        if (wave == 0) {
            const float lf = nlf, li = nli;
            float bs = lf;
#pragma unroll
            for (int o = 1; o < 64; o <<= 1) { const float t = shl_(bs, lane - o); if (lane >= o) bs += t; }
            bcs[lane] = bs; lis[lane] = li;
        }
        __syncthreads();
#pragma unroll
        for (int n = 0; n < 2; ++n) { const int p = tid + 512 * n, row = p >> 4, pc = p & 15;
            *(LAS v4u*)(qs + row * QP + pc * 16) = qv[n]; *(LAS v4u*)(ksm + row * QP + pc * 16) = kv[n];
            const float eb = fexp(bcs[row]); v4u e;
#pragma unroll
            for (int w = 0; w < 4; ++w) e[w] = pk2(bflo(qv[n][w]) * eb, bfhi(qv[n][w]) * eb);
            *(LAS v4u*)(Ap + row * APP + 128 + pc * 16) = e; }
#pragma unroll
        for (int n = 0; n < 2; ++n)
#pragma unroll
            for (int i = 0; i < 8; ++i) *(LAS unsigned*)(vT + (8 * (pcg + 16 * n) + i) * VTP + lp * 4) = elem16(va[n], i) | (elem16(vb[n], i) << 16);
        { const int nu = unit + nblk; if (nu < 2048) M3_LOAD(nu, nqv, nkv, nva, nvb, nlf, nli); }
        __syncthreads();
        {
            const int jt = wave >> 1, j = 16 * jt + fr; const float bj = bcs[j];
#pragma unroll
            for (int sti = 0; sti < 2; ++sti) { const int st = 2 * (wave & 1) + sti;
                f32x4 acc = (f32x4){0.f, 0.f, 0.f, 0.f};
#pragma unroll
                for (int ks = 0; ks < 4; ++ks) { const bf16x8 kf = *(const LAS bf16x8*)(ksm + (16 * st + fr) * QP + (32 * ks + 8 * fg) * 2); const bf16x8 qf = *(const LAS bf16x8*)(qs + j * QP + (32 * ks + 8 * fg) * 2); acc = MFMA16(kf, qf, acc); }
                float val[4]; float rs = 0.f;
#pragma unroll
                for (int jj = 0; jj < 4; ++jj) { const int s = 16 * st + 4 * fg + jj; const float wgt = (s <= j) ? fexp(bj - bcs[s] + lis[s]) : 0.f; val[jj] = (s <= j) ? acc[jj] * KSCALE * wgt : 0.f; rs += val[jj]; }
                rs += shx(rs, 16, lane); rs += shx(rs, 32, lane);
                if (fg == 0) rsum[j * 4 + st] = rs;
                v2u w; w.x = pk2(val[0], val[1]); w.y = pk2(val[2], val[3]);
                *(LAS v2u*)(Ap + j * APP + (16 * st + 4 * fg) * 2) = w; }
        }
        {
            const v4u q0 = *(const LAS v4u*)(qs + j2 * QP + part * 32), q1 = *(const LAS v4u*)(qs + j2 * QP + part * 32 + 16);
            float s = 0.f;
#pragma unroll
            for (int w = 0; w < 4; ++w) { s += bflo(q0[w]) * nv[w >> 1][(2 * w) & 3] + bfhi(q0[w]) * nv[w >> 1][(2 * w + 1) & 3]; s += bflo(q1[w]) * nv[2 + (w >> 1)][(2 * w) & 3] + bfhi(q1[w]) * nv[2 + (w >> 1)][(2 * w + 1) & 3]; }
            s += shx(s, 1, lane); s += shx(s, 2, lane); s += shx(s, 4, lane);
            if (part == 0) denq[j2] = fexp(bcs[j2]) * s;
        }
        __syncthreads();
        f32x4 acc2[2][4];
#pragma unroll
        for (int et = 0; et < 2; ++et)
#pragma unroll
            for (int jt = 0; jt < 4; ++jt) acc2[et][jt] = (f32x4){0.f, 0.f, 0.f, 0.f};
#pragma unroll
        for (int ks = 0; ks < 6; ++ks) {
            bf16x8 af[2];
#pragma unroll
            for (int et = 0; et < 2; ++et) af[et] = (ks < 2) ? *(const LAS bf16x8*)(vT + (32 * wave + 16 * et + fr) * VTP + (32 * ks + 8 * fg) * 2) : __builtin_bit_cast(bf16x8, cf[et][(ks < 2) ? 0 : ks - 2]);
#pragma unroll
            for (int jt = 0; jt < 4; ++jt) { const bf16x8 bq = *(const LAS bf16x8*)(Ap + (16 * jt + fr) * APP + (32 * ks + 8 * fg) * 2);
#pragma unroll
                for (int et = 0; et < 2; ++et) acc2[et][jt] = MFMA16(af[et], bq, acc2[et][jt]); }
        }
        __syncthreads();
#pragma unroll
        for (int et = 0; et < 2; ++et)
#pragma unroll
            for (int jt = 0; jt < 4; ++jt) *(LAS f32x4*)(Hs + (16 * jt + fr) * HSP + 32 * wave + 16 * et + 4 * fg) = acc2[et][jt];
        __syncthreads();
        {
            const float den = (rsum[j2 * 4] + rsum[j2 * 4 + 1]) + (rsum[j2 * 4 + 2] + rsum[j2 * 4 + 3]) + denq[j2];
            const float inv = 1.f / fmaxf(fabsf(den), 1.f);
            float hv[4][8]; float ss = 0.f;
#pragma unroll
            for (int i = 0; i < 4; ++i) {
                const f32x4 h0 = *(const LAS f32x4*)(Hs + j2 * HSP + 64 * i + 8 * part) * inv, h1 = *(const LAS f32x4*)(Hs + j2 * HSP + 64 * i + 8 * part + 4) * inv;
                hv[i][0] = h0.x; hv[i][1] = h0.y; hv[i][2] = h0.z; hv[i][3] = h0.w; hv[i][4] = h1.x; hv[i][5] = h1.y; hv[i][6] = h1.z; hv[i][7] = h1.w;
#pragma unroll
                for (int u = 0; u < 8; ++u) ss += hv[i][u] * hv[i][u]; }
            ss += shx(ss, 1, lane); ss += shx(ss, 2, lane); ss += shx(ss, 4, lane);
            const float r = rsqrtf(ss * (1.f / 256.f) + EPS);
#pragma unroll
            for (int i = 0; i < 4; ++i) { const int e = 64 * i + 8 * part;
                const v4u ov = ovp[i];
                const f32x4 g0 = *(const f32x4*)(gh + h * 256 + e), g1 = *(const f32x4*)(gh + h * 256 + e + 4);
                const float gg[8] = {g0.x, g0.y, g0.z, g0.w, g1.x, g1.y, g1.z, g1.w};
                v4u o;
#pragma unroll
                for (int w = 0; w < 4; ++w) { const float x0 = hv[i][2 * w] * r * gg[2 * w], x1 = hv[i][2 * w + 1] * r * gg[2 * w + 1];
                    const float o0 = bflo(ov[w]), o1 = bfhi(ov[w]);
                    o[w] = pk2(x0 / (1.f + fexp(-o0)), x1 / (1.f + fexp(-o1))); }
                *(v4u*)(YA + (t0 + j2) * DM + h * 256 + e) = o; }
        }
        __syncthreads();
    }
}

#define XB_TMO      128
#define XB_XCNT(j)  (256  + 64 * (j))
#define XB_XSUB(j)  (1280 + 64 * (j))
#define XB_XGEN(j)  (2304 + 64 * (j))
#define XB_TOP      3328
#define XB_TOPGEN   3392
#define XCD_BAR_WORDS 3456
#define XB_SPIN_CAP (1u << 18)

__device__ __forceinline__ unsigned xb_ld(unsigned* p)              { return __hip_atomic_load(p, __ATOMIC_RELAXED, __HIP_MEMORY_SCOPE_AGENT); }
__device__ __forceinline__ unsigned xb_add(unsigned* p, unsigned v) { return __hip_atomic_fetch_add(p, v, __ATOMIC_RELAXED, __HIP_MEMORY_SCOPE_AGENT); }
__device__ __forceinline__ unsigned xb_xcc_id() { return (unsigned)__builtin_amdgcn_s_getreg((3 << 11) | 20) & 0xFu; }
#define XB_SPIN(cond, bar) do { unsigned _sp = 0; while (cond) { __builtin_amdgcn_s_sleep(1); \
    if ((++_sp & 255u) == 0u) { if (xb_ld(&(bar)[XB_TMO])) break; if (_sp > XB_SPIN_CAP) { atomicAdd(&(bar)[XB_TMO], 1u); break; } } } } while (0)

struct XcdBarrier {
    unsigned* bar; unsigned x;
    volatile LAS unsigned* st;
};

__device__ __forceinline__ XcdBarrier xcd_barrier_post(unsigned* bar, volatile LAS unsigned* st) {
    XcdBarrier b; b.bar = bar; b.x = xb_xcc_id(); b.st = st;
    if (threadIdx.x == 0) (void)xb_add(&bar[XB_XCNT(b.x)], 1u);
    return b;
}
__device__ __forceinline__ void xcd_barrier_complete(unsigned* bar, unsigned x, unsigned& nloc, unsigned& nx) {
    const unsigned G = gridDim.x * gridDim.y * gridDim.z;
    unsigned sum, cnt, mine, sp = 0u;
    for (;;) {
        sum = 0u; cnt = 0u; mine = 0u;
#pragma unroll
        for (unsigned j = 0; j < 16; ++j) { const unsigned c = xb_ld(&bar[XB_XCNT(j)]); sum += c; cnt += (c > 0u) ? 1u : 0u; mine = (j == x) ? c : mine; }
        if (sum == G) break;
        __builtin_amdgcn_s_sleep(1);
        if ((++sp & 255u) == 0u) { if (xb_ld(&bar[XB_TMO])) break; if (sp > XB_SPIN_CAP) { atomicAdd(&bar[XB_TMO], 1u); break; } }
    }
    nloc = mine > 0u ? mine : 1u; nx = cnt > 0u ? cnt : 1u;
}

__device__ __forceinline__ void xcd_barrier(const XcdBarrier& b) {
    asm volatile("s_waitcnt vmcnt(0)" ::: "memory");
    __syncthreads();
    if (threadIdx.x == 0) {
        unsigned* bar = b.bar; asm volatile("" : "+s"(bar));
        __builtin_amdgcn_s_waitcnt(0);
        unsigned nloc = b.st[0], nx = b.st[1];
        if (nloc == 0u) { xcd_barrier_complete(bar, b.x, nloc, nx); b.st[0] = nloc; b.st[1] = nx; }
        const unsigned old = xb_add(&bar[XB_XSUB(b.x)], 1u);
        const unsigned gen = old / nloc;
        if (old + 1u == (gen + 1u) * nloc) {
            __builtin_amdgcn_fence(__ATOMIC_RELEASE, "agent");
            asm volatile("s_waitcnt vmcnt(0)" ::: "memory");
            const unsigned og = xb_add(&bar[XB_TOP], 1u);
            const unsigned tg = og / nx;
            if (og + 1u == (tg + 1u) * nx) xb_add(&bar[XB_TOPGEN], 1u);
            else XB_SPIN(xb_ld(&bar[XB_TOPGEN]) == tg, bar);
            __builtin_amdgcn_fence(__ATOMIC_ACQUIRE, "agent");
            xb_add(&bar[XB_XGEN(b.x)], 1u);
            asm volatile("s_waitcnt vmcnt(0)" ::: "memory");
        } else {
            XB_SPIN(xb_ld(&bar[XB_XGEN(b.x)]) == gen, bar);
            __builtin_amdgcn_fence(__ATOMIC_ACQUIRE, "agent");
            asm volatile("s_waitcnt vmcnt(0)" ::: "memory");
        }
    }
    __syncthreads();
}

__global__ void __launch_bounds__(NTHR, 2) mk_fwd(Args a) {
    extern __shared__ __attribute__((aligned(16))) unsigned char lds_raw[];
    LAS unsigned char* lds = (LAS unsigned char*)lds_raw;
    const int ph_lo = __builtin_amdgcn_readfirstlane(a.ph_lo_), ph_hi = __builtin_amdgcn_readfirstlane(a.ph_hi_);
    for (int u = threadIdx.x; u < 16; u += NTHR) ((LAS unsigned*)(lds + LDS_BYTES - 64))[u] = 0u;
    __syncthreads();
    XcdBarrier xbar; xbar.bar = (unsigned*)a.ws + CW_BAR; xbar.x = xb_xcc_id(); xbar.st = (volatile LAS unsigned*)(lds + LDS_BYTES - 64);
    if (ph_hi - ph_lo > 1 && blockIdx.x == 0) { unsigned* bw = (unsigned*)a.ws + CW_BAR; for (int i = threadIdx.x; i < XCD_BAR_WORDS; i += NTHR) __hip_atomic_store(bw + i, 0u, __ATOMIC_RELAXED, __HIP_MEMORY_SCOPE_AGENT); }
    const int nblk = gridDim.x, NGW = nblk * NWAVES, nthr = nblk * NTHR;
    unsigned char* ws = a.ws;
    bf16* XN = (bf16*)(ws + WS_XN); bf16* PROJ = (bf16*)(ws + WS_PROJ); bf16* STb = (bf16*)(ws + WS_ST); bf16* YA = (bf16*)(ws + WS_YA);
    bf16* Qb = (bf16*)(ws + WS_Q); bf16* Kb = (bf16*)(ws + WS_K); bf16* Vb = (bf16*)(ws + WS_V); bf16* Ob = (bf16*)(ws + WS_O); bf16* Hb = (bf16*)(ws + WS_H);
    float* ROPE = (float*)(ws + WS_ROPE); float* Gt = (float*)(ws + WS_G); float* DEC = (float*)(ws + WS_DEC); float* NST = (float*)(ws + WS_NST);
    for (int ph = ph_lo; ph < ph_hi; ++ph) {
        if (ph > ph_lo) { if (ph == ph_lo + 1) { cg::this_grid().sync(); if (threadIdx.x == 0) (void)xb_add(&xbar.bar[XB_XCNT(xbar.x)], 1u); }   else xcd_barrier(xbar); }
        if (ph > 18 && (ph - 19) % 7 == 1) {
            int bxa = blockIdx.x; asm volatile("" : "+s"(bxa));
            const attn_body::AttnTensors AT{(const attn_body::bf16*)Qb, (const attn_body::bf16*)Kb, (const attn_body::bf16*)Vb, (attn_body::bf16*)Ob};
#ifndef NO_ATTN
            const int Lb = (ph - 19) / 7;
            const float* lam = a.b_lam + (size_t)Lb * 256; int tq = threadIdx.x; asm volatile("" : "+v"(tq)); const int ln = tq & 63;
            const float s01 = wave_sum(lam[ln] * lam[64 + ln], ln), s23 = wave_sum(lam[128 + ln] * lam[192 + ln], ln);
            const float lamf = __int_as_float(__builtin_amdgcn_readfirstlane(__float_as_int(fexp(s01) - fexp(s23) + a.lam_init[Lb])));
            const attn_body::Comb CB{(attn_body::bf16*)YA, a.b_g_head + (size_t)Lb * DM, lamf, a.lam_init[Lb]};
            attn_body::attn_phase<8>((char*)lds_raw, AT, CB, nblk, bxa);
#endif
            continue;
        }
        int tid_o = threadIdx.x, bx_o = blockIdx.x; asm volatile("" : "+v"(tid_o)); asm volatile("" : "+s"(bx_o));
        const int tid = tid_o, bx = bx_o, lane = tid & 63, wave = __builtin_amdgcn_readfirstlane(tid >> 6), gw = bx * NWAVES + wave, gtid = bx * NTHR + tid;
        if (ph == 0) {
            conv_weights(a, 0, lds, gw, NGW, wave, lane);
            rope_table(a.pos, ROPE, gtid, nthr);
            __syncthreads();
            NormJob J{a.x, nullptr, nullptr, nullptr, a.norm_g, XN, nullptr, nullptr, a.a_w_in + NPROJ, a.a_b_gates, Gt};
            norm_phase(J, lds, gw, NGW, tid, lane);
            continue;
        }
        int L, sub;
        if (ph <= 18) { L = (ph - 1) / 9; sub = (ph - 1) % 9; } else { const int q = ph - 19, sb = q % 7; L = 2 + q / 7; sub = sb + (sb >= 2 ? 2 : sb); }
        const bool isA = L < 2;
        if (sub == 0 || sub == 4 || sub == 6 || sub == 7) {
            const int ng = (sub == 0 && L == 2) ? 2 : 1;
            for (int gi = 0; gi < ng; ++gi) {
                pg8::Gemm g; pg8::EpiBf16 E; E.act = 0; E.split_cols = 0; E.split_stride = 0; E.scale0 = 1.f; E.rope = nullptr; E.rope_cols = 0;
                if (sub == 0) {
                    if (isA) { g = pg8::Gemm{XN, (const bf16*)(ws + WS_WA), TT, NPROJ, DM}; E.O = PROJ; E.ldc = NPROJ; }
                    else if (gi == 0) { g = pg8::Gemm{XN, (const bf16*)(ws + WS_WA), TT, DM, DM}; E.O = Qb; E.ldc = DM; E.split_cols = DM; E.scale0 = attn_body::C2; E.rope = ROPE; E.rope_cols = DM; }
                    else { g = pg8::Gemm{YA, (const bf16*)(ws + WS_WA) + (size_t)DM * DM, TT, 2 * DM, DM}; E.O = Kb; E.ldc = DM; E.split_cols = DM; E.split_stride = (WS_V - WS_K) / 2; E.rope = ROPE; E.rope_cols = DM; }
                } else if (sub == 4) { g = pg8::Gemm{YA, (const bf16*)(ws + WS_WO), TT, DM, DM}; E.O = XN; E.ldc = DM; }
                else if (sub == 6) { g = pg8::Gemm{XN, (const bf16*)(ws + WS_WU), TT, FF, DM}; E.O = Hb; E.ldc = FF; E.act = 2; }
                else { g = pg8::Gemm{Hb, (const bf16*)(ws + WS_WD), TT, DM, FF}; E.O = XN; E.ldc = DM; }
                pg8::StaticOrder S; S.init(g.M, g.N, nblk, bx);
#ifndef NO_GEMM
                for (int rp = 0; rp < PROBE_GEMM; ++rp) pg8::gemm_phase<pg8::EpiBf16, pg8::StaticOrder, true, true>(lds, g, S, E);
#endif
            }
        } else if (sub == 5 || sub == 8) {
            NormJob J{(L == 0 && sub == 5) ? a.x : a.out, a.out, XN, a.norm_g + (size_t)(L * 4 + (sub == 5 ? 1 : 3)) * DM, nullptr, XN, nullptr, nullptr, nullptr, nullptr, Gt};
            if (sub == 5) J.gpre = a.norm_g + (size_t)(L * 4 + 2) * DM;
            else if (L < 3) {
                conv_weights(a, L + 1, lds, gw, NGW, wave, lane);
                __syncthreads();
                J.gpre = a.norm_g + (size_t)((L + 1) * 4) * DM;
                if (L + 1 < 2) { J.wg = a.a_w_in + (size_t)(L + 1) * DM * MPROJ + NPROJ; J.bg = a.a_b_gates + (L + 1) * 8; }
                if (L + 1 == 2) { J.gkv = a.kv_norm_g; J.XKV = YA; }
            }
            norm_phase(J, lds, gw, NGW, tid, lane);
        } else if (isA) {
#ifndef NO_M
            if (sub == 1) for (int rp = 0; rp < PROBE_M; ++rp) m1_phase(lds, PROJ, Gt, STb, DEC, NST, nblk, bx, tid, lane, wave);
            else if (sub == 2) m2_phase(STb, DEC, NST, gtid, nthr);
            else for (int rp = 0; rp < PROBE_M; ++rp) m3_phase(lds, PROJ, Gt, STb, NST, a.a_g_head + (size_t)L * DM, YA, nblk, bx, tid, lane, wave);
#endif
        } else {
        }
    }
}

extern "C" void kernel_launch(void* const* d_in, const int* in_sizes, int n_in, void* d_out, int out_size, void* d_ws, size_t ws_size, hipStream_t stream) {
    static int grid = 0;
    if (grid == 0) {
        if (n_in != 15 || in_sizes[0] != TT * DM || out_size != TT * DM || ws_size < WS_END) { fprintf(stderr, "kernel_launch: unexpected shapes / workspace (n_in %d, in0 %d, out %d, ws %zu); nothing launched\n", n_in, n_in > 0 ? in_sizes[0] : -1, out_size, ws_size); grid = -1; return; }
        int dev = 0, cus = 0, per_cu = 0;
        if (hipGetDevice(&dev) != hipSuccess || hipDeviceGetAttribute(&cus, hipDeviceAttributeMultiprocessorCount, dev) != hipSuccess) { grid = -1; return; }
        if (hipFuncSetAttribute((const void*)mk_fwd, hipFuncAttributeMaxDynamicSharedMemorySize, LDS_BYTES) != hipSuccess) { fprintf(stderr, "kernel_launch: hipFuncSetAttribute failed\n"); grid = -1; return; }
        if (hipOccupancyMaxActiveBlocksPerMultiprocessor(&per_cu, (const void*)mk_fwd, NTHR, LDS_BYTES) != hipSuccess || per_cu < 1) per_cu = 1;
        (void)hipGetLastError();
        grid = cus * per_cu;
    }
    if (grid < 0) return;
    Args a{};
    a.x = (const float*)d_in[0]; a.pos = (const int*)d_in[1]; a.norm_g = (const float*)d_in[2]; a.a_w_in = (const float*)d_in[3]; a.a_b_gates = (const float*)d_in[4];
    a.a_g_head = (const float*)d_in[5]; a.a_w_out = (const float*)d_in[6]; a.kv_norm_g = (const float*)d_in[7]; a.w_kv = (const float*)d_in[8]; a.b_w_q = (const float*)d_in[9];
    a.b_lam = (const float*)d_in[10]; a.b_g_head = (const float*)d_in[11]; a.b_w_out = (const float*)d_in[12]; a.mlp_up = (const float*)d_in[13]; a.mlp_down = (const float*)d_in[14];
    a.out = (float*)d_out; a.ws = (unsigned char*)d_ws;
    a.lam_init[0] = (float)(0.8 - 0.6 * exp(-0.3 * 2.0)); a.lam_init[1] = (float)(0.8 - 0.6 * exp(-0.3 * 3.0));
#if MK_MULTI
    for (int ph = 0; ph < NPH; ++ph) { a.ph_lo_ = ph; a.ph_hi_ = ph + 1; hipLaunchKernelGGL(mk_fwd, dim3(grid), dim3(NTHR), LDS_BYTES, stream, a); }
#else
    a.ph_lo_ = 0; a.ph_hi_ = NPH;
    void* args[] = {&a};
    hipError_t e = hipLaunchCooperativeKernel((const void*)mk_fwd, dim3(grid), dim3(NTHR), args, LDS_BYTES, stream);
    if (e != hipSuccess) fprintf(stderr, "cooperative launch failed: %s (grid %d)\n", hipGetErrorString(e), grid);
#endif
}
```

```cpp
#include <hip/hip_runtime.h>
#include <hip/hip_cooperative_groups.h>
#include <cstdio>
#include <cstdint>
#include <cmath>
namespace pg8 {
#define PG8_LAS __attribute__((address_space(3)))
typedef unsigned short bf16_t;
typedef short bf16x8 __attribute__((ext_vector_type(8)));
typedef float f32x4 __attribute__((ext_vector_type(4)));
typedef unsigned u32x4 __attribute__((ext_vector_type(4)));
constexpr int BM = 256, BK = 64, HALF = 128, HTB = HALF * BK * 2  , STAGE_BYTES = 8 * HTB, NXCD = 8, WGM = 8;

__host__ __device__ __forceinline__ int lds_byte(int r, int c) { const int st = (r >> 4) * 2 + (c >> 5), rr = r & 15, cc = c & 31, ob = rr * 64 + cc * 2; return st * 1024 + (ob ^ (((ob >> 9) & 1) << 5)); }
__host__ __device__ __forceinline__ void stage_rc(int b, int& R, int& C) { const int st = b / 1024, sb = b % 1024, swz = sb ^ (((sb >> 9) & 1) << 5); R = (st >> 1) * 16 + swz / 64; C = (st & 1) * 32 + (swz % 64) / 2; }
__host__ __device__ __forceinline__ int perm32(int rho) { const int n = rho >> 4, i = rho & 15; return 8 * (i >> 2) + 4 * n + (i & 3); }

struct Unit { int pm, pn; };
struct Gemm { const bf16_t* A; const bf16_t* Bt; int M, N, K; };

struct StaticOrder {
    int nM, nN, nwg, G, c;
    __host__ __device__ void init(int M, int N, int G_, int c_) { nM = M / BM; nN = N / BM; nwg = nM * nN; G = G_; c = c_; }
    __host__ __device__ bool next(int i, Unit& u) const {
        const long L = (long)i * G + c; if (L >= nwg) return false;
        int wgid = (int)L; { const int q = nwg / NXCD, r = nwg % NXCD, xcd = wgid % NXCD, off = wgid / NXCD; wgid = (xcd < r ? xcd * (q + 1) : r * (q + 1) + (xcd - r) * q) + off; }
        const int nig = WGM * nN, gid = wgid / nig, fm = gid * WGM, gsz = (nM - fm) < WGM ? (nM - fm) : WGM;
        u.pm = fm + ((wgid % nig) % gsz); u.pn = (wgid % nig) / gsz; return true;
    }
    __device__ __forceinline__ void a_ready(const Unit&) const {}
    __device__ __forceinline__ void done(const Unit&) const {}
};

__device__ __forceinline__ unsigned cvt_pk_bf16(float lo, float hi) { unsigned r; asm volatile("v_cvt_pk_bf16_f32 %0, %1, %2" : "=v"(r) : "v"(lo), "v"(hi)); return r; }
typedef float f32x2 __attribute__((ext_vector_type(2)));
struct EpiBf16 {
    static constexpr bool PERM = true, AFTER_DRAIN = false;
    bf16_t* O; int ldc; int act; int split_cols; size_t split_stride; float scale0; const float* rope; int rope_cols;
    __device__ __forceinline__ void operator()(const f32x4 (&acc)[2][2][4][2], const Unit& u, int wr, int wc, int fr, int fq) const {
        const int row0 = u.pm * BM + wr * 64 + fr; int colt = u.pn * BM; bf16_t* base = O;
        float sc = 1.f; if (split_cols) { const int t = colt / split_cols; base += (size_t)t * split_stride; colt -= t * split_cols; if (t == 0) sc = scale0; }
        const int col0 = colt + wc * 32 + 8 * fq;
        if (rope != nullptr && u.pn * BM < rope_cols) {
            typedef unsigned u32x2 __attribute__((ext_vector_type(2)));
#pragma unroll
            for (int ai = 0; ai < 2; ++ai)
#pragma unroll
                for (int m = 0; m < 4; ++m) { const size_t row = (size_t)(row0 + ai * HALF + m * 16);
#pragma unroll
                    for (int bj = 0; bj < 2; ++bj) { const int gc = col0 + bj * HALF, hd6 = gc & ~63, m4 = ((gc & 63) >> 3) * 4;
                        const float* tp = rope + row * 64 + m4; const f32x4 cs = *(const f32x4*)tp, sn = *(const f32x4*)(tp + 32);
                        const f32x4 v0 = acc[ai][bj][m][0], v1 = acc[ai][bj][m][1];
                        const f32x4 o1 = (v0 * cs - v1 * sn) * sc, o2 = (v1 * cs + v0 * sn) * sc;
                        u32x2 w1, w2; w1.x = cvt_pk_bf16(o1[0], o1[1]); w1.y = cvt_pk_bf16(o1[2], o1[3]); w2.x = cvt_pk_bf16(o2[0], o2[1]); w2.y = cvt_pk_bf16(o2[2], o2[3]);
                        bf16_t* rp = base + row * ldc + hd6 + m4; *(u32x2*)rp = w1; *(u32x2*)(rp + 32) = w2; } }
            return;
        }
#pragma unroll
        for (int ai = 0; ai < 2; ++ai)
#pragma unroll
            for (int m = 0; m < 4; ++m) { bf16_t* rowp = base + (size_t)(row0 + ai * HALF + m * 16) * ldc + col0;
#pragma unroll
                for (int bj = 0; bj < 2; ++bj) { f32x4 v0 = acc[ai][bj][m][0], v1 = acc[ai][bj][m][1];
                    if (act == 2) {
#pragma unroll
                        for (int e = 0; e < 4; ++e) { const float a0 = fmaxf(v0[e], 0.f), a1 = fmaxf(v1[e], 0.f); v0[e] = a0 * a0; v1[e] = a1 * a1; } }
                    v0 = v0 * sc; v1 = v1 * sc; u32x4 w; w.x = cvt_pk_bf16(v0[0], v0[1]); w.y = cvt_pk_bf16(v0[2], v0[3]); w.z = cvt_pk_bf16(v1[0], v1[1]); w.w = cvt_pk_bf16(v1[2], v1[3]);
                    *(u32x4*)(rowp + bj * HALF) = w; } }
    }
};

template <class Epi, class Sched, bool ALIGN_EPI = false, bool SP2 = false>
__device__ __forceinline__ void gemm_phase(PG8_LAS unsigned char* lds, const Gemm g, const Sched& S, const Epi& E) {
    int tid_o = threadIdx.x; asm volatile("" : "+v"(tid_o));
    const int tid = tid_o, wid = __builtin_amdgcn_readfirstlane(tid >> 6), lane = tid & 63, wr = wid >> 2, wc = wid & 3, fr = lane & 15, fq = lane >> 4;
    const int K = g.K, nt = K / BK;
    unsigned voffA[2], voffB[2];
#pragma unroll
    for (int i = 0; i < 2; ++i) { int R, C; stage_rc(tid * 16 + i * 8192, R, C); const int Rb = Epi::PERM ? ((R & ~31) + perm32(R & 31)) : R;
        voffA[i] = (unsigned)(R * K + C) * 2u; voffB[i] = (unsigned)(Rb * K + C) * 2u; }
    const size_t kstep = (size_t)(BK * 2);
    const size_t hstep = (size_t)HALF * K * 2;
    const size_t tstep = 2 * hstep;
    const unsigned ldsw = (unsigned)wid * 1024u;
    const int aoff = lds_byte(wr * 64 + fr, fq * 8), boff = lds_byte(wc * 32 + fr, fq * 8);
#define PG8_SA(b, h) (((b) * 2 + (h)) * HTB)
#define PG8_SB(b, h) ((4 + (b) * 2 + (h)) * HTB)
#define PG8_STAGE(bufoff, gbase, voff) do { _Pragma("unroll") for (int _i = 0; _i < 2; ++_i) \
        __builtin_amdgcn_global_load_lds((const unsigned*)((const char*)(gbase) + (voff)[_i]), (PG8_LAS unsigned*)(lds + (bufoff) + ldsw + _i * 8192), 16, 0, 0); } while (0)
#define PG8_LDA(dst, b, h) do { _Pragma("unroll") for (int m = 0; m < 4; ++m) _Pragma("unroll") for (int k = 0; k < 2; ++k) dst[m][k] = *(const PG8_LAS bf16x8*)(lds + PG8_SA(b, h) + aoff + m * 2048 + k * 1024); } while (0)
#define PG8_LDB(dst, b, h) do { _Pragma("unroll") for (int n = 0; n < 2; ++n) _Pragma("unroll") for (int k = 0; k < 2; ++k) dst[n][k] = *(const PG8_LAS bf16x8*)(lds + PG8_SB(b, h) + boff + n * 2048 + k * 1024); } while (0)
#define PG8_MMA(ai, bj, At, Bt) do { __builtin_amdgcn_s_setprio(1); _Pragma("unroll") for (int m = 0; m < 4; ++m) _Pragma("unroll") for (int n = 0; n < 2; ++n) _Pragma("unroll") for (int k = 0; k < 2; ++k) \
        acc[ai][bj][m][n] = __builtin_amdgcn_mfma_f32_16x16x32_bf16(Bt[n][k], At[m][k], acc[ai][bj][m][n], 0, 0, 0); __builtin_amdgcn_s_setprio(0); } while (0)
#define PG8_WAIT_V(n) asm volatile("s_waitcnt vmcnt(" #n ")" ::: "memory")
#define PG8_WAIT_L(n) asm volatile("s_waitcnt lgkmcnt(" #n ")" ::: "memory")
#define PG8_BAR __builtin_amdgcn_s_barrier()
#define PG8_SCHED __builtin_amdgcn_sched_barrier(0)
    Unit cur, nxt; int ui = 0;
    if (!S.next(0, cur)) return;
    f32x4 acc[2][2][4][2];
#pragma unroll
    for (int a = 0; a < 2; ++a)
#pragma unroll
        for (int b = 0; b < 2; ++b)
#pragma unroll
            for (int m = 0; m < 4; ++m)
#pragma unroll
                for (int n = 0; n < 2; ++n) acc[a][b][m][n] = (f32x4){0.f, 0.f, 0.f, 0.f};
    bf16x8 At[4][2], B0[2][2], B1[2][2];
    const char* cA = (const char*)g.A + (size_t)cur.pm * tstep; const char* cB = (const char*)g.Bt + (size_t)cur.pn * tstep;
    S.a_ready(cur);
    if constexpr (SP2) {
        PG8_STAGE(PG8_SB(0, 0), cB, voffB); PG8_STAGE(PG8_SB(0, 1), cB + hstep, voffB); PG8_STAGE(PG8_SA(0, 0), cA, voffA); PG8_STAGE(PG8_SA(0, 1), cA + hstep, voffA);
        if (wr == 1) PG8_BAR;
        PG8_WAIT_V(2); PG8_BAR;
        PG8_STAGE(PG8_SB(1, 0), cB + kstep, voffB); PG8_STAGE(PG8_SA(1, 0), cA + kstep, voffA); PG8_STAGE(PG8_SB(1, 1), cB + hstep + kstep, voffB);
        PG8_WAIT_V(6); PG8_BAR;
    } else {
        PG8_STAGE(PG8_SB(0, 0), cB, voffB); PG8_STAGE(PG8_SA(0, 0), cA, voffA); PG8_STAGE(PG8_SB(0, 1), cB + hstep, voffB); PG8_STAGE(PG8_SA(0, 1), cA + hstep, voffA);
        if (wr == 1) PG8_BAR;
        PG8_WAIT_V(4); PG8_BAR;
        PG8_STAGE(PG8_SB(1, 0), cB + kstep, voffB); PG8_STAGE(PG8_SA(1, 0), cA + kstep, voffA); PG8_STAGE(PG8_SB(1, 1), cB + hstep + kstep, voffB);
        PG8_WAIT_V(6); PG8_BAR;
    }
    for (;;) {
        const bool has_next = S.next(ui + 1, nxt);
        const char* nA = has_next ? (const char*)g.A + (size_t)nxt.pm * tstep : cA; const char* nB = has_next ? (const char*)g.Bt + (size_t)nxt.pn * tstep : cB;
        for (int t = 0; t < nt; t += 2) {
            const bool last = (t == nt - 2);
            const char* a1 = cA + (size_t)(t + 1) * kstep;
            const char* a2 = last ? nA : cA + (size_t)(t + 2) * kstep; const char* b2 = last ? nB : cB + (size_t)(t + 2) * kstep;
            const char* a3 = a2 + kstep; const char* b3 = b2 + kstep;
            if (last && has_next) S.a_ready(nxt);
            if constexpr (SP2) {
            PG8_LDB(B0, 0, 0); PG8_LDB(B1, 0, 1); PG8_SCHED; PG8_LDA(At, 0, 0); PG8_STAGE(PG8_SA(1, 1), a1 + hstep, voffA);
            PG8_WAIT_V(8); PG8_WAIT_L(0); PG8_BAR; PG8_MMA(0, 0, At, B0); PG8_MMA(0, 1, At, B1); PG8_BAR; PG8_SCHED;
            PG8_LDA(At, 0, 1); PG8_STAGE(PG8_SB(0, 0), b2, voffB); PG8_STAGE(PG8_SB(0, 1), b2 + hstep, voffB); PG8_STAGE(PG8_SA(0, 0), a2, voffA);
            PG8_WAIT_V(8); PG8_WAIT_L(0); PG8_BAR; PG8_MMA(1, 0, At, B0); PG8_MMA(1, 1, At, B1); PG8_BAR; PG8_SCHED;
            PG8_LDB(B0, 1, 0); PG8_LDB(B1, 1, 1); PG8_SCHED; PG8_LDA(At, 1, 0); PG8_STAGE(PG8_SA(0, 1), a2 + hstep, voffA);
            PG8_WAIT_V(8); PG8_WAIT_L(0); PG8_BAR; PG8_MMA(0, 0, At, B0); PG8_MMA(0, 1, At, B1); PG8_BAR; PG8_SCHED;
            PG8_LDA(At, 1, 1); PG8_STAGE(PG8_SB(1, 0), b3, voffB); PG8_STAGE(PG8_SB(1, 1), b3 + hstep, voffB); PG8_STAGE(PG8_SA(1, 0), a3, voffA);
            PG8_WAIT_V(8); PG8_WAIT_L(0); PG8_BAR; PG8_MMA(1, 0, At, B0); PG8_MMA(1, 1, At, B1); PG8_BAR; PG8_SCHED;
            } else {
            PG8_LDB(B0, 0, 0); PG8_SCHED; PG8_LDA(At, 0, 0); PG8_STAGE(PG8_SA(1, 1), a1 + hstep, voffA);
            PG8_WAIT_L(8); PG8_BAR; PG8_WAIT_L(0); PG8_MMA(0, 0, At, B0); PG8_BAR; PG8_SCHED;
            PG8_LDB(B1, 0, 1); PG8_STAGE(PG8_SB(0, 0), b2, voffB);
            PG8_BAR; PG8_WAIT_L(0); PG8_MMA(0, 1, At, B1); PG8_BAR;
            PG8_LDA(At, 0, 1); PG8_STAGE(PG8_SA(0, 0), a2, voffA);
            PG8_BAR; PG8_WAIT_L(0); PG8_MMA(1, 0, At, B0); PG8_BAR; PG8_SCHED;
            PG8_STAGE(PG8_SB(0, 1), b2 + hstep, voffB);
            PG8_WAIT_V(6); PG8_BAR; PG8_MMA(1, 1, At, B1); PG8_BAR;
            PG8_LDB(B0, 1, 0); PG8_SCHED; PG8_LDA(At, 1, 0); PG8_STAGE(PG8_SA(0, 1), a2 + hstep, voffA);
            PG8_WAIT_L(8); PG8_BAR; PG8_WAIT_L(0); PG8_MMA(0, 0, At, B0); PG8_BAR; PG8_SCHED;
            PG8_LDB(B1, 1, 1); PG8_STAGE(PG8_SB(1, 0), b3, voffB);
            PG8_BAR; PG8_WAIT_L(0); PG8_MMA(0, 1, At, B1); PG8_BAR;
            PG8_LDA(At, 1, 1); PG8_STAGE(PG8_SA(1, 0), a3, voffA);
            PG8_BAR; PG8_WAIT_L(0); PG8_MMA(1, 0, At, B0); PG8_BAR; PG8_SCHED;
            PG8_STAGE(PG8_SB(1, 1), b3 + hstep, voffB);
            PG8_WAIT_V(6); PG8_BAR; PG8_MMA(1, 1, At, B1); PG8_BAR;
            }
        }
        if constexpr (ALIGN_EPI) { if (wr == 0) PG8_BAR; }
        if constexpr (!Epi::AFTER_DRAIN) { E(acc, cur, wr, wc, fr, fq); S.done(cur); }
        if (!has_next) break;
#pragma unroll
        for (int a = 0; a < 2; ++a)
#pragma unroll
            for (int b = 0; b < 2; ++b)
#pragma unroll
                for (int m = 0; m < 4; ++m)
#pragma unroll
                    for (int n = 0; n < 2; ++n) acc[a][b][m][n] = (f32x4){0.f, 0.f, 0.f, 0.f};
        cur = nxt; cA = nA; cB = nB; ++ui;
        if constexpr (ALIGN_EPI) { if (wr == 1) PG8_BAR; }
    }
    PG8_WAIT_V(0);
    if constexpr (!ALIGN_EPI) { if (wr == 0) PG8_BAR; }
    PG8_BAR;
    if constexpr (Epi::AFTER_DRAIN) { E.fused(acc, cur, wr, wc, fr, fq, lds, wid, lane); S.done(cur); }
#undef PG8_SA
#undef PG8_SB
#undef PG8_STAGE
#undef PG8_LDA
#undef PG8_LDB
#undef PG8_MMA
#undef PG8_WAIT_V
#undef PG8_WAIT_L
#undef PG8_BAR
#undef PG8_SCHED
}
}

#include <hip/hip_bf16.h>
#include <cmath>
namespace attn_body {
using bf16=__hip_bfloat16;
using bf16x8=__attribute__((ext_vector_type(8)))short;
using s16x4=__attribute__((ext_vector_type(4)))short;
using f32x16=__attribute__((ext_vector_type(16)))float;
using u32x4=__attribute__((ext_vector_type(4)))unsigned;
constexpr int BATCH=2,NHEAD=16,SEQ=16384,D=64,DM=NHEAD*D,OPITCH=2048;
constexpr int NW=8,QBLK=32,QB=QBLK*NW,KVBLK=64,NQB=SEQ/QB;
constexpr int ATTN_PITCH=DM, ATTN_UNIT_ROWS=QB;
__device__ __forceinline__ int crow(int r,int hi){return (r&3)+8*(r>>2)+4*hi;}
#define SBAR() __builtin_amdgcn_sched_barrier(0)
__device__ __forceinline__ void cmask(f32x16&p0,f32x16&p1,int jb,int qrel,int hi){
  const float NEG=-INFINITY; int kb=64*jb+4*hi;
  #pragma unroll
  for(int r=0;r<16;++r){int kv=kb+(r&3)+8*(r>>2); if(kv>qrel)p0[r]=NEG; if(kv+32>qrel)p1[r]=NEG;}
}

constexpr int NSLOT=3, SLOTB=8192;
constexpr int LDS_K=0, LDS_V=NSLOT*SLOTB, LDS_V2=2*NSLOT*SLOTB, LDS_WS=3*NSLOT*SLOTB, LDS_OST=LDS_WS+NW*64*4, LDS_BYTES=LDS_OST+NW*8192;
constexpr float C2=0.125f*1.4426950408889634f;
__device__ __forceinline__ void glds16(const void*gsrc,unsigned lds_dst){unsigned keep;
  asm volatile("s_mov_b32 %0, m0\n\ts_mov_b32 m0, %2\n\ts_nop 0\n\tglobal_load_lds_dwordx4 %1, off\n\ts_mov_b32 m0, %0":"=&s"(keep):"v"(gsrc),"s"(lds_dst):"memory");}
__device__ __forceinline__ float max3f(float a,float b,float c){float r;asm("v_max3_f32 %0, %1, %2, %3":"=v"(r):"v"(a),"v"(b),"v"(c));return r;}
__device__ __forceinline__ float max2f(float a,float b){float r;asm("v_max_f32_e32 %0, %1, %2":"=v"(r):"v"(a),"v"(b));return r;}
__device__ __forceinline__ float fadd_s(float a,float b){float r;asm("v_add_f32_e32 %0, %1, %2":"=v"(r):"v"(a),"v"(b));return r;}
__device__ __forceinline__ float fsub_s(float a,float b){float r;asm("v_sub_f32_e32 %0, %1, %2":"=v"(r):"v"(a),"v"(b));return r;}
typedef float f32x2_t __attribute__((ext_vector_type(2))); typedef __bf16 bf16x2_t __attribute__((ext_vector_type(2)));
__device__ __forceinline__ unsigned cvtpk_s(float lo,float hi){f32x2_t v={lo,hi};bf16x2_t b=__builtin_convertvector(v,bf16x2_t);return __builtin_bit_cast(unsigned,b);}
#define WAIT_BAR(N) asm volatile("s_waitcnt vmcnt(" #N ") lgkmcnt(0)\n\ts_barrier":::"memory")

__device__ __forceinline__ void qkt(f32x16&p0,f32x16&p1,const char*Kslot,const bf16x8*qr,const f32x16&negm,int r32,int hi){
  const char*kb=Kslot+hi*1024+r32*16;
  #pragma unroll
  for(int d0=0;d0<4;++d0){
    const bf16x8 b0=*reinterpret_cast<const bf16x8*>(kb+d0*2048);
    const bf16x8 b1=*reinterpret_cast<const bf16x8*>(kb+d0*2048+512);
    if(d0==0){p0=__builtin_amdgcn_mfma_f32_32x32x16_bf16(b0,qr[0],negm,0,0,0);p1=__builtin_amdgcn_mfma_f32_32x32x16_bf16(b1,qr[0],negm,0,0,0);}
    else{p0=__builtin_amdgcn_mfma_f32_32x32x16_bf16(b0,qr[d0],p0,0,0,0);p1=__builtin_amdgcn_mfma_f32_32x32x16_bf16(b1,qr[d0],p1,0,0,0);}}
}
typedef __attribute__((address_space(3))) const char* lds_cptr;
typedef short v4i16_t __attribute__((ext_vector_type(4)));
__device__ __forceinline__ void kload8(bf16x8*kf,lds_cptr kp){
  kf[0]=*(const __attribute__((address_space(3))) bf16x8*)(kp);      kf[1]=*(const __attribute__((address_space(3))) bf16x8*)(kp+512);
  kf[2]=*(const __attribute__((address_space(3))) bf16x8*)(kp+2048); kf[3]=*(const __attribute__((address_space(3))) bf16x8*)(kp+2560);
  kf[4]=*(const __attribute__((address_space(3))) bf16x8*)(kp+4096); kf[5]=*(const __attribute__((address_space(3))) bf16x8*)(kp+4608);
  kf[6]=*(const __attribute__((address_space(3))) bf16x8*)(kp+6144); kf[7]=*(const __attribute__((address_space(3))) bf16x8*)(kp+6656);
}
__device__ __forceinline__ void kload2(bf16x8*kf,lds_cptr kp,int j){ kf[2*j]=*(const __attribute__((address_space(3))) bf16x8*)(kp+j*2048); kf[2*j+1]=*(const __attribute__((address_space(3))) bf16x8*)(kp+j*2048+512); }
__device__ __forceinline__ s16x4 vtr(lds_cptr p){ return __builtin_bit_cast(s16x4,__builtin_amdgcn_ds_read_tr16_b64_v4i16((__attribute__((address_space(3))) v4i16_t*)p)); }
__device__ __forceinline__ float rowmax(const f32x16&p0,const f32x16&p1){
  float a=max3f(p0[0],p0[1],p1[0]),b=max3f(p0[2],p0[3],p1[1]);a=max3f(a,p1[2],p1[3]);
  #pragma unroll
  for(int r=4;r<16;r+=4){a=max3f(a,p0[r],p0[r+1]);b=max3f(b,p0[r+2],p0[r+3]);a=max3f(a,p1[r],p1[r+1]);b=max3f(b,p1[r+2],p1[r+3]);}
  const float m=max2f(a,b);
  auto rr=__builtin_amdgcn_permlane32_swap(__float_as_uint(m),__float_as_uint(m),false,false);
  return max2f(__uint_as_float(rr[0]),__uint_as_float(rr[1]));
}
__device__ __forceinline__ void pv(f32x16*o,int vb,bf16x8 pa0,bf16x8 pa1,bf16x8 pa2,bf16x8 pa3){
  #pragma unroll
  for(int d0=0;d0<2;++d0){s16x4 lo[4],hi[4];
    #pragma unroll
    for(int ks=0;ks<4;++ks){
      asm volatile("ds_read_b64_tr_b16 %0,%1 offset:%c2":"=&v"(lo[ks]):"v"(vb),"i"(d0*4096+ks*1024):"memory");
      asm volatile("ds_read_b64_tr_b16 %0,%1 offset:%c2":"=&v"(hi[ks]):"v"(vb),"i"(d0*4096+ks*1024+512):"memory");}
    asm volatile("s_waitcnt lgkmcnt(0)":::"memory");SBAR();
    #define PK(k) (bf16x8){lo[k][0],lo[k][1],lo[k][2],lo[k][3],hi[k][0],hi[k][1],hi[k][2],hi[k][3]}
    o[d0]=__builtin_amdgcn_mfma_f32_32x32x16_bf16(pa0,PK(0),o[d0],0,0,0);
    o[d0]=__builtin_amdgcn_mfma_f32_32x32x16_bf16(pa1,PK(1),o[d0],0,0,0);
    o[d0]=__builtin_amdgcn_mfma_f32_32x32x16_bf16(pa2,PK(2),o[d0],0,0,0);
    o[d0]=__builtin_amdgcn_mfma_f32_32x32x16_bf16(pa3,PK(3),o[d0],0,0,0);
    #undef PK
  }
}

#ifndef ATTN_STORE16
#define ATTN_STORE16(p,v) (*(u32x4*)(p)=(v))
#endif
struct Comb { bf16* XA; const float* gh; float lamf, lam_init; };
template<int THRL> __device__ __forceinline__ void attn_unit(int b,int qcol,int vcol,int ocol,int qb,const bf16*Q,const bf16*__restrict__ K,const bf16*__restrict__ V,bf16*O,char*shm,bool comb,const Comb&CB){
  int tid_o=threadIdx.x; asm volatile("":"+v"(tid_o)); const int tid=tid_o,lane=tid&63,r32=lane&31,hi=lane>>5; const int wid=__builtin_amdgcn_readfirstlane(tid>>6);
  const long rowbase=(long)b*SEQ; const int q0=qb*QB;
  const bf16*Qw=Q+(rowbase+q0+wid*QBLK)*DM+qcol;
  const bf16*Kh=K+rowbase*DM+qcol,*Vh=V+rowbase*DM+vcol;
  const unsigned lds0=(unsigned)(uintptr_t)shm;
  float*wsf=(float*)(shm+LDS_WS)+wid*64;
  const bf16*ksrc=Kh+(long)lane*DM+wid*8;
  const bf16*vsrc=Vh+(long)(16*(wid&3)+(lane>>2))*DM+(wid>>2)*32+(lane&3)*8;
  const unsigned kdst=lds0+LDS_K+wid*1024, vdst=lds0+LDS_V+wid*1024;
  #define DMA_K(t,slot) glds16(ksrc+(long)(t)*KVBLK*DM,(unsigned)__builtin_amdgcn_readfirstlane(kdst+(slot)))
  #define DMA_V(t,slot) do{ glds16(vsrc+(long)(t)*KVBLK*DM,(unsigned)__builtin_amdgcn_readfirstlane(vdst+(slot))); glds16(vsrc+64+(long)(t)*KVBLK*DM,(unsigned)__builtin_amdgcn_readfirstlane(vdst+(LDS_V2-LDS_V)+(slot))); }while(0)
  const int vb0=(int)(lds0+LDS_V)+((lane>>4)&1)*32+(lane&3)*8+(4*hi+((lane&15)>>2))*64;
  const char*Kbase=shm+LDS_K; bf16x8 kf[8];
  const lds_cptr shm3=(lds_cptr)shm; const lds_cptr kp0=shm3+LDS_K+hi*1024+r32*16; const lds_cptr vp0=shm3+LDS_V+((lane>>4)&1)*32+(lane&3)*8+(4*hi+((lane&15)>>2))*64;
  const int NT=(q0+QB)/KVBLK;
  DMA_K(0,0);DMA_V(0,0);DMA_K(1,SLOTB);
  bf16x8 qr[4];
  #pragma unroll
  for(int d0=0;d0<4;++d0)qr[d0]=*reinterpret_cast<const bf16x8*>(&Qw[(long)r32*DM+d0*16+hi*8]);
  __attribute__((address_space(3))) char*qst=(__attribute__((address_space(3))) char*)(shm3+LDS_OST+wid*8192+lane*16);
  #pragma unroll
  for(int d0=0;d0<4;++d0)*(__attribute__((address_space(3))) bf16x8*)(qst+d0*1024)=qr[d0];
  #define QRD(k) (*(const __attribute__((address_space(3))) bf16x8*)(qst+(k)*1024))
  float mhat=0.f,l_reg=0.f;f32x16 o[4];o[0]=f32x16{};o[1]=f32x16{};o[2]=f32x16{};o[3]=f32x16{};f32x16 negm=f32x16{};asm volatile("":"+v"(negm));
  const int qrel=wid*QBLK+r32;
  #define CMASK(P0,P1,t) do{int jb_=(t)-(NT-4); if(jb_>=0)cmask(P0,P1,jb_,qrel,hi);}while(0)
  bool resc=false;
  #define START(P0,P1) do{ const float rm=rowmax(P0,P1); resc=false; \
    { const float dl=rm; mhat=fadd_s(mhat,dl); \
      _Pragma("unroll") for(int r=0;r<16;++r){P0[r]=fsub_s(P0[r],dl);P1[r]=fsub_s(P1[r],dl);} \
      _Pragma("unroll") for(int r=0;r<16;++r)negm[r]=-mhat; asm volatile("":"+v"(negm)); } \
    _Pragma("unroll") for(int r=0;r<16;++r)P0[r]=__builtin_amdgcn_exp2f(P0[r]); }while(0)
  #define RESC() do{ if(resc){ asm volatile("s_waitcnt lgkmcnt(0)":::"memory"); \
      _Pragma("unroll") for(int d_=0;d_<4;++d_) _Pragma("unroll") for(int r=0;r<16;++r)o[d_][r]*=wsf[crow(r,hi)]; } }while(0)
  f32x16 pA0,pA1,pB0,pB1;
  int sl_prev=0,sl_cur=0,sl_next=SLOTB;
  #define ROT() do{sl_prev=sl_cur;sl_cur=sl_next;sl_next=(sl_next==(NSLOT-1)*SLOTB)?0:sl_next+SLOTB;}while(0)
  DMA_K(2,2*SLOTB);
  WAIT_BAR(3);
  qkt(pA0,pA1,Kbase,qr,negm,r32,hi);asm volatile("s_nop 15\n\ts_nop 7":"+v"(pA0),"+v"(pA1));CMASK(pA0,pA1,0);
  START(pA0,pA1);
  _Pragma("unroll") for(int r=0;r<16;++r)pA1[r]=__builtin_amdgcn_exp2f(pA1[r]);
  WAIT_BAR(0);
  DMA_K(3,0);DMA_V(1,SLOTB);
  ROT();
  kload8(kf,kp0+sl_cur);
  WAIT_BAR(3);
  s16x4 vlo[8],vhi[8]; u32x4 pw0,pw1,pw2,pw3;
  #define PKW(P,B) cvtpk_s(P[B],P[B+1])
  #define PAF(k) __builtin_bit_cast(bf16x8,pw##k)
  typedef float f32x4_t __attribute__((ext_vector_type(4)));
  #define PAFS(P,b) __builtin_bit_cast(bf16x8,(f32x4_t){P[b],P[(b)+1],P[(b)+2],P[(b)+3]})
  float dummy_pin=0.f;
  #define VFR(i) (bf16x8){vlo[i][0],vlo[i][1],vlo[i][2],vlo[i][3],vhi[i][0],vhi[i][1],vhi[i][2],vhi[i][3]}
  #define PIN(x) asm volatile("":"+v"(x))
  #define MX3(a,b,c) __builtin_fmaxf(__builtin_fmaxf((a),(b)),(c))
  #define GAPA(MF,A0,A1,A2,A3,W0,W1,PW) do{ MF; sacc+=(f32x2_t){A0,A1}; sacc+=(f32x2_t){A2,A3}; PIN(sacc); W0; W1; PIN(PW); SBAR(); }while(0)
  #define EX(v) __builtin_amdgcn_exp2f(v)
  #define GAPB(MF,X,B) do{ MF; X[B]=EX(X[B]); X[B+1]=EX(X[B+1]); X[B+2]=EX(X[B+2]); X[B+3]=EX(X[B+3]); PIN(X); SBAR(); }while(0)
  #define GAPB2(MF,X,B) do{ MF; X[B]=EX(X[B]); X[B+1]=EX(X[B+1]); PIN(X); SBAR(); }while(0)
  #define VRD(i) do{ vlo[i]=vtr(vp_+(((i)>>2)*4096+((i)&3)*1024)); vhi[i]=vtr(vp_+(((i)>>2)*4096+((i)&3)*1024+512)); }while(0)
  #define VRD2(i) do{ vlo[i]=vtr(vp_+((LDS_V2-LDS_V)+((i)>>2)*4096+((i)&3)*1024)); vhi[i]=vtr(vp_+((LDS_V2-LDS_V)+((i)>>2)*4096+((i)&3)*1024+512)); SBAR(); }while(0)
  #define KRD(G,j) do{ if(G){ kload2(kf,kp0+sl_next,j); SBAR(); } }while(0)
  #define STEP(C0,C1,P0,P1,t,GK,GV,GL) do{ SBAR(); \
    const lds_cptr vp_=vp0+sl_prev; \
    VRD(0); SBAR(); f32x2_t sacc={P0[0],P0[1]}; \
    GAPA(C0=__builtin_amdgcn_mfma_f32_32x32x16_bf16(kf[0],qr[0],negm,0,0,0), P0[2],P0[3],P0[4],P0[5],     P0[0]=__uint_as_float(PKW(P0,0)), P0[1]=__uint_as_float(PKW(P0,2)), dummy_pin); \
    VRD(4); SBAR(); GAPA(C1=__builtin_amdgcn_mfma_f32_32x32x16_bf16(kf[1],qr[0],negm,0,0,0), P0[6],P0[7],P0[8],P0[9],     P0[2]=__uint_as_float(PKW(P0,4)), P0[3]=__uint_as_float(PKW(P0,6)), dummy_pin); \
    VRD(1); SBAR(); const bf16x8 qq1_=QRD(1); GAPA(C0=__builtin_amdgcn_mfma_f32_32x32x16_bf16(kf[2],qq1_,C0,0,0,0),   P0[10],P0[11],P0[12],P0[13], P0[4]=__uint_as_float(PKW(P0,8)), P0[5]=__uint_as_float(PKW(P0,10)), dummy_pin); \
    VRD(5); SBAR(); GAPA(C1=__builtin_amdgcn_mfma_f32_32x32x16_bf16(kf[3],qq1_,C1,0,0,0),   P0[14],P0[15],P1[0],P1[1],   P0[6]=__uint_as_float(PKW(P0,12)), P0[7]=__uint_as_float(PKW(P0,14)), dummy_pin); \
    VRD(2); SBAR(); const bf16x8 qq2_=QRD(2); GAPA(C0=__builtin_amdgcn_mfma_f32_32x32x16_bf16(kf[4],qq2_,C0,0,0,0),   P1[2],P1[3],P1[4],P1[5],     P1[0]=__uint_as_float(PKW(P1,0)), P1[1]=__uint_as_float(PKW(P1,2)), dummy_pin); \
    VRD(6); SBAR(); GAPA(C1=__builtin_amdgcn_mfma_f32_32x32x16_bf16(kf[5],qq2_,C1,0,0,0),   P1[6],P1[7],P1[8],P1[9],     P1[2]=__uint_as_float(PKW(P1,4)), P1[3]=__uint_as_float(PKW(P1,6)), dummy_pin); \
    VRD(3); SBAR(); const bf16x8 qq3_=QRD(3); GAPA(C0=__builtin_amdgcn_mfma_f32_32x32x16_bf16(kf[6],qq3_,C0,0,0,0),   P1[10],P1[11],P1[12],P1[13], P1[4]=__uint_as_float(PKW(P1,8)), P1[5]=__uint_as_float(PKW(P1,10)), dummy_pin); \
    VRD(7); SBAR(); GAPA(C1=__builtin_amdgcn_mfma_f32_32x32x16_bf16(kf[7],qq3_,C1,0,0,0),   P1[14],P1[15],0.f,0.f,       P1[6]=__uint_as_float(PKW(P1,12)), P1[7]=__uint_as_float(PKW(P1,14)), dummy_pin); \
    l_reg+=sacc.x+sacc.y; \
    if(GK){DMA_K((t)+3,sl_cur);} if(GV){DMA_V((t)+1,sl_next);} \
    CMASK(C0,C1,t); \
    { float a=MX3(C0[0],C0[1],C1[0]),b=MX3(C0[2],C0[3],C1[1]); a=MX3(a,C1[2],C1[3]); \
      _Pragma("unroll") for(int r=4;r<16;r+=4){a=MX3(a,C0[r],C0[r+1]);b=MX3(b,C0[r+2],C0[r+3]);a=MX3(a,C1[r],C1[r+1]);b=MX3(b,C1[r+2],C1[r+3]);} \
      float rm=__builtin_fmaxf(a,b); { auto rr=__builtin_amdgcn_permlane32_swap(__float_as_uint(rm),__float_as_uint(rm),false,false); rm=__builtin_fmaxf(__uint_as_float(rr[0]),__uint_as_float(rr[1])); } \
      resc=false; \
      if(__builtin_expect(__any(rm>(float)THRL),0)){ const float dl=__builtin_fmaxf(rm,0.f); mhat+=dl; \
        _Pragma("unroll") for(int r=0;r<16;++r){C0[r]-=dl;C1[r]-=dl;} \
        _Pragma("unroll") for(int r=0;r<16;++r)negm[r]=-mhat; asm volatile("":"+v"(negm)); \
        const float f=__builtin_amdgcn_exp2f(-dl); l_reg*=f; if(hi==0)wsf[r32]=f; resc=true; } } \
    SBAR(); \
    GAPB2(o[0]=__builtin_amdgcn_mfma_f32_32x32x16_bf16(PAFS(P0,0),VFR(0),o[0],0,0,0), C0,0); VRD2(0); \
    GAPB2(o[1]=__builtin_amdgcn_mfma_f32_32x32x16_bf16(PAFS(P0,0),VFR(4),o[1],0,0,0), C0,2); VRD2(4); \
    KRD(GL,0); GAPB2(o[0]=__builtin_amdgcn_mfma_f32_32x32x16_bf16(PAFS(P0,4),VFR(1),o[0],0,0,0), C0,4); VRD2(1); \
    KRD(GL,1); GAPB2(o[1]=__builtin_amdgcn_mfma_f32_32x32x16_bf16(PAFS(P0,4),VFR(5),o[1],0,0,0), C0,6); VRD2(5); \
    KRD(GL,2); GAPB2(o[0]=__builtin_amdgcn_mfma_f32_32x32x16_bf16(PAFS(P1,0),VFR(2),o[0],0,0,0), C0,8); VRD2(2); \
    KRD(GL,3); GAPB2(o[1]=__builtin_amdgcn_mfma_f32_32x32x16_bf16(PAFS(P1,0),VFR(6),o[1],0,0,0), C0,10); VRD2(6); \
    GAPB2(o[0]=__builtin_amdgcn_mfma_f32_32x32x16_bf16(PAFS(P1,4),VFR(3),o[0],0,0,0), C0,12); VRD2(3); \
    GAPB2(o[1]=__builtin_amdgcn_mfma_f32_32x32x16_bf16(PAFS(P1,4),VFR(7),o[1],0,0,0), C0,14); VRD2(7); \
    GAPB2(o[2]=__builtin_amdgcn_mfma_f32_32x32x16_bf16(PAFS(P0,0),VFR(0),o[2],0,0,0), C1,0); \
    GAPB2(o[3]=__builtin_amdgcn_mfma_f32_32x32x16_bf16(PAFS(P0,0),VFR(4),o[3],0,0,0), C1,2); \
    GAPB2(o[2]=__builtin_amdgcn_mfma_f32_32x32x16_bf16(PAFS(P0,4),VFR(1),o[2],0,0,0), C1,4); \
    GAPB2(o[3]=__builtin_amdgcn_mfma_f32_32x32x16_bf16(PAFS(P0,4),VFR(5),o[3],0,0,0), C1,6); \
    GAPB2(o[2]=__builtin_amdgcn_mfma_f32_32x32x16_bf16(PAFS(P1,0),VFR(2),o[2],0,0,0), C1,8); \
    GAPB2(o[3]=__builtin_amdgcn_mfma_f32_32x32x16_bf16(PAFS(P1,0),VFR(6),o[3],0,0,0), C1,10); \
    GAPB2(o[2]=__builtin_amdgcn_mfma_f32_32x32x16_bf16(PAFS(P1,4),VFR(3),o[2],0,0,0), C1,12); \
    GAPB2(o[3]=__builtin_amdgcn_mfma_f32_32x32x16_bf16(PAFS(P1,4),VFR(7),o[3],0,0,0), C1,14); \
    }while(0)
  int t=1;
  #undef CMASK
  #define CMASK(P0,P1,t) do{}while(0)
  for(;t+5<NT;t+=2){
    STEP(pB0,pB1,pA0,pA1,t,true,true,true);     WAIT_BAR(3); RESC(); ROT();
    STEP(pA0,pA1,pB0,pB1,t+1,true,true,true);   WAIT_BAR(3); RESC(); ROT();
  }
  #undef CMASK
  #define CMASK(P0,P1,t) do{int jb_=(t)-(NT-4); if(jb_>=0)cmask(P0,P1,jb_,qrel,hi);}while(0)
  #define ENDW(tt) do{ if((tt)+3<NT){WAIT_BAR(3);} else if((tt)+2<NT){WAIT_BAR(2);} else {WAIT_BAR(0);} }while(0)
  for(;t+1<NT;t+=2){
    STEP(pB0,pB1,pA0,pA1,t,(t+3<NT),(t+1<NT),(t+1<NT));       ENDW(t);   RESC(); ROT();
    STEP(pA0,pA1,pB0,pB1,t+1,(t+4<NT),(t+2<NT),(t+2<NT));     ENDW(t+1); RESC(); ROT();
  }
  STEP(pB0,pB1,pA0,pA1,NT-1,false,false,false); RESC();
  { float sacc=pB0[0]+pB0[1]; _Pragma("unroll") for(int r=2;r<16;++r)sacc+=pB0[r]; _Pragma("unroll") for(int r=0;r<16;++r)sacc+=pB1[r]; l_reg+=sacc;
    pw0=(u32x4){PKW(pB0,0),PKW(pB0,2),PKW(pB0,4),PKW(pB0,6)};pw1=(u32x4){PKW(pB0,8),PKW(pB0,10),PKW(pB0,12),PKW(pB0,14)};pw2=(u32x4){PKW(pB1,0),PKW(pB1,2),PKW(pB1,4),PKW(pB1,6)};pw3=(u32x4){PKW(pB1,8),PKW(pB1,10),PKW(pB1,12),PKW(pB1,14)};
    SBAR(); pv(o,vb0+sl_cur,PAF(0),PAF(1),PAF(2),PAF(3)); pv(o+2,vb0+(LDS_V2-LDS_V)+sl_cur,PAF(0),PAF(1),PAF(2),PAF(3)); }
  #undef PKW
  #undef PAF
  #undef PAFS
  #undef VFR
  #undef PIN
  #undef MX3
  #undef GAPA
  #undef GAPB
  #undef GAPB2
  #undef EX
  #undef VRD
  #undef VRD2
  #undef QRD
  #undef KRD
  #undef STEP
  #undef ENDW
  {auto rr=__builtin_amdgcn_permlane32_swap(__float_as_uint(l_reg),__float_as_uint(l_reg),false,false);l_reg=__uint_as_float(rr[0])+__uint_as_float(rr[1]);}
  if(hi==0)wsf[32+r32]=l_reg;asm volatile("s_waitcnt lgkmcnt(0)":::"memory");
  float rli[16];
  #pragma unroll
  for(int r=0;r<16;++r)rli[r]=__builtin_amdgcn_rcpf(wsf[32+crow(r,hi)]);
  bf16*Ow=O+(rowbase+q0+wid*QBLK)*OPITCH+ocol;
  { bf16*stg=(bf16*)(shm+LDS_OST)+wid*4096;
    #pragma unroll
    for(int r=0;r<16;++r){const int orow=crow(r,hi);
      #pragma unroll
      for(int d0=0;d0<4;++d0)stg[orow*128+d0*32+r32]=__float2bfloat16(o[d0][r]*rli[r]);}
    asm volatile("s_waitcnt lgkmcnt(0)":::"memory");
    if(!comb){
      #pragma unroll
      for(int i=0;i<8;++i){const int row=i*4+(lane>>4),ch=lane&15; const u32x4 v=*(const u32x4*)(stg+row*128+ch*8); ATTN_STORE16(Ow+(long)row*OPITCH+ch*8,v);}
    } else {
      const int hcol=(ocol>>8)*128; const float post=1.f-CB.lam_init;
      #pragma unroll
      for(int i=0;i<8;++i){const int row=i*4+(lane>>4),ch=lane&15;
        const u32x4 v1=*(const u32x4*)(stg+row*128+ch*8); const u32x4 v0=*(const u32x4*)(Ow-128+(long)row*OPITCH+ch*8);
        float d[8]; float ss=0.f;
        #pragma unroll
        for(int w=0;w<4;++w){ d[2*w]=__uint_as_float(v0[w]<<16)-CB.lamf*__uint_as_float(v1[w]<<16); d[2*w+1]=__uint_as_float(v0[w]&0xffff0000u)-CB.lamf*__uint_as_float(v1[w]&0xffff0000u); ss+=d[2*w]*d[2*w]+d[2*w+1]*d[2*w+1]; }
        _Pragma("unroll") for(int sx=1;sx<16;sx<<=1) ss+=__int_as_float(__builtin_amdgcn_ds_bpermute((lane^sx)<<2,__float_as_int(ss)));
        const float rn=rsqrtf(ss*(1.f/128.f)+1e-6f)*post;
        const float*gp=CB.gh+hcol+ch*8; const float4 g0=*(const float4*)gp,g1=*(const float4*)(gp+4);
        u32x4 ov; ov[0]=cvtpk_s(d[0]*rn*g0.x,d[1]*rn*g0.y); ov[1]=cvtpk_s(d[2]*rn*g0.z,d[3]*rn*g0.w); ov[2]=cvtpk_s(d[4]*rn*g1.x,d[5]*rn*g1.y); ov[3]=cvtpk_s(d[6]*rn*g1.z,d[7]*rn*g1.w);
        *(u32x4*)(CB.XA+(rowbase+q0+wid*QBLK+row)*DM+hcol+ch*8)=ov; }
    } }
  asm volatile("s_waitcnt lgkmcnt(0)\n\ts_barrier":::"memory");
  #undef DMA_K
  #undef DMA_V
  #undef CMASK
  #undef START
  #undef RESC
  #undef ROT
}
constexpr int ATTN_LDS_BYTES=LDS_BYTES;
struct AttnTensors { const bf16* Q; const bf16* K; const bf16* V; bf16* O; };
template<int THRL=8> __device__ __forceinline__ void attn_phase(char*lds,const AttnTensors&T,const Comb&CB,int grid,int block){
  const bool fast=(grid==256);
  for(int i=0;;++i){
    int bh,j;
    if(fast){ if(i>=8)break; bh=(i>>2)*8+(block&7); j=block>>3; }
    else { const long p=(long)(i>>2)*grid+block; if(p>=16*32)break; bh=(int)(p>>5); j=(int)(p&31); }
    const int c=i&1, qb=(i&2)?(NQB-1-j):j, b=bh>>3, vh=(bh&7)*2+c;
    attn_unit<THRL>(b,vh*64,(vh>>1)*128,vh*128,qb,T.Q,T.K,T.V,T.O,lds,c==1,CB);
  }
}
#undef SBAR
#undef WAIT_BAR
}

namespace cg = cooperative_groups;
#define LAS __attribute__((address_space(3)))
typedef unsigned short bf16;
typedef unsigned v4u __attribute__((ext_vector_type(4)));
typedef unsigned v2u __attribute__((ext_vector_type(2)));
typedef float f32x4 __attribute__((ext_vector_type(4)));
typedef short bf16x8 __attribute__((ext_vector_type(8)));
#ifndef PROBE_ATTN
#define PROBE_ATTN 1
#endif
#ifndef PROBE_GEMM
#define PROBE_GEMM 1
#endif
#ifndef PROBE_M
#define PROBE_M 1
#endif
#ifndef MK_MULTI
#define MK_MULTI 0
#endif
constexpr int NWAVES = 8, NTHR = 512;
constexpr int BATCH = 2, SEQ = 16384, DM = 1024, TT = BATCH * SEQ, FF = 4096;
constexpr int MPROJ = 3080, NPROJ = 3072;
constexpr float EPS = 1e-6f;
constexpr float KSCALE = 0.08838834764831845f;
constexpr int NPH = 33;
constexpr size_t MiB = 1u << 20;
constexpr size_t WS_WA = 2 * MiB, WS_WO = 8 * MiB, WS_WU = 10 * MiB, WS_WD = 18 * MiB;
constexpr size_t WS_XN = 32 * MiB;
constexpr size_t WS_K = 96 * MiB, WS_V = 160 * MiB;
constexpr size_t WS_PROJ = 96 * MiB;
constexpr size_t WS_ST = 288 * MiB;
constexpr size_t WS_YA = 416 * MiB;
constexpr size_t WS_Q = 224 * MiB;
constexpr size_t WS_O = 288 * MiB;
constexpr size_t WS_H = 224 * MiB;
constexpr size_t WS_ROPE = 480 * MiB;
constexpr size_t WS_G = 488 * MiB;
constexpr size_t WS_DEC = 489 * MiB;
constexpr size_t WS_NST = 490 * MiB;
constexpr size_t WS_END = 491 * MiB;
constexpr int CW_BAR = 4096;
constexpr size_t CTL_ZERO_BYTES = 65536;
constexpr int LDS_BYTES = 147456;

struct Args {
    const float* x; const int* pos; const float* norm_g; const float* a_w_in; const float* a_b_gates; const float* a_g_head; const float* a_w_out;
    const float* kv_norm_g; const float* w_kv; const float* b_w_q; const float* b_lam; const float* b_g_head; const float* b_w_out;
    const float* mlp_up; const float* mlp_down; float* out; unsigned char* ws;
    float lam_init[2]; int ph_lo_, ph_hi_;
};

__device__ __forceinline__ unsigned f2bf(float f) { unsigned u = __builtin_bit_cast(unsigned, f); return (u + 0x7fffu + ((u >> 16) & 1u)) >> 16; }
__device__ __forceinline__ unsigned pk2(float lo, float hi) { return f2bf(lo) | (f2bf(hi) << 16); }
__device__ __forceinline__ float bflo(unsigned w) { return __uint_as_float(w << 16); }
__device__ __forceinline__ float bfhi(unsigned w) { return __uint_as_float(w & 0xffff0000u); }
__device__ __forceinline__ float shx(float v, int o, int lane) { return __int_as_float(__builtin_amdgcn_ds_bpermute((lane ^ o) << 2, __float_as_int(v))); }
__device__ __forceinline__ float shl_(float v, int src) { return __int_as_float(__builtin_amdgcn_ds_bpermute(src << 2, __float_as_int(v))); }
__device__ __forceinline__ float wave_sum(float v, int lane) {
#pragma unroll
    for (int o = 1; o < 64; o <<= 1) v += shx(v, o, lane);
    return v;
}
__device__ __forceinline__ float fexp(float x) { return __builtin_amdgcn_exp2f(x * 1.4426950408889634f); }
#define MFMA16(a, b, c) __builtin_amdgcn_mfma_f32_16x16x32_bf16((a), (b), (c), 0, 0, 0)

__device__ __forceinline__ int rope_perm(int c) { const int w = c & 63; return (c & ~63) + 8 * ((w & 31) >> 2) + 4 * (w >> 5) + (w & 3); }
__device__ __forceinline__ void transpose_item(const float* W, int K, int ldw, int N, bf16* WT, LAS float* scr, int item, int lane, int perm_lim) {
    const int nblk = N / 32, kb = item / nblk, nb = item % nblk, k0 = 64 * kb, n0 = 32 * nb;
    float wv[32];
#pragma unroll
    for (int i = 0; i < 32; ++i) wv[i] = W[(size_t)(k0 + 2 * i + (lane >> 5)) * ldw + n0 + (lane & 31)];
#pragma unroll
    for (int i = 0; i < 32; ++i) scr[(2 * i + (lane >> 5)) * 33 + (lane & 31)] = wv[i];
    asm volatile("s_waitcnt lgkmcnt(0)" ::: "memory");
    const int c = lane & 7;
#pragma unroll
    for (int j = 0; j < 4; ++j) { const int n = (lane >> 3) + 8 * j; const LAS float* s = scr + (8 * c) * 33 + n;
        v4u o; o.x = pk2(s[0 * 33], s[1 * 33]); o.y = pk2(s[2 * 33], s[3 * 33]); o.z = pk2(s[4 * 33], s[5 * 33]); o.w = pk2(s[6 * 33], s[7 * 33]);
        const int nn = n0 + n, nd = (nn < perm_lim) ? rope_perm(nn) : nn;
        *(v4u*)(WT + (size_t)nd * K + k0 + 8 * c) = o; }
    asm volatile("s_waitcnt lgkmcnt(0)" ::: "memory");
}
__device__ __forceinline__ void conv_weights(const Args& a, int L, LAS unsigned char* lds, int gw, int NGW, int wave, int lane) {
    LAS float* scr = (LAS float*)(lds + wave * 16384);
    unsigned char* ws = a.ws;
    const float* W0; int K0, ld0, N0; const float* W1 = nullptr; int N1 = 0, ld1 = 0;
    const float* Wo;
    if (L < 2) { W0 = a.a_w_in + (size_t)L * DM * MPROJ; K0 = DM; ld0 = MPROJ; N0 = NPROJ; Wo = a.a_w_out + (size_t)L * DM * DM; }
    else { W0 = a.b_w_q + (size_t)(L - 2) * DM * DM; K0 = DM; ld0 = DM; N0 = DM; Wo = a.b_w_out + (size_t)(L - 2) * DM * DM; if (L == 2) { W1 = a.w_kv; N1 = 2 * DM; ld1 = 2 * DM; } }
    const float* Wu = a.mlp_up + (size_t)L * DM * FF; const float* Wd = a.mlp_down + (size_t)L * FF * DM;
    const int I0 = (K0 / 64) * (N0 / 32), I1 = (DM / 64) * (N1 / 32), IO = (DM / 64) * (DM / 32), IU = (DM / 64) * (FF / 32), ID = (FF / 64) * (DM / 32);
    const int NIT = I0 + I1 + IO + IU + ID;
    for (int it = gw; it < NIT; it += NGW) {
        int r = it;
        if (r < I0) { transpose_item(W0, K0, ld0, N0, (bf16*)(ws + WS_WA), scr, r, lane, (L >= 2) ? DM : 0); continue; } r -= I0;
        if (r < I1) { transpose_item(W1, DM, ld1, N1, (bf16*)(ws + WS_WA) + (size_t)DM * DM, scr, r, lane, DM); continue; } r -= I1;
        if (r < IO) { transpose_item(Wo, DM, DM, DM, (bf16*)(ws + WS_WO), scr, r, lane, 0); continue; } r -= IO;
        if (r < IU) { transpose_item(Wu, DM, FF, FF, (bf16*)(ws + WS_WU), scr, r, lane, 0); continue; } r -= IU;
        transpose_item(Wd, FF, DM, DM, (bf16*)(ws + WS_WD), scr, r, lane, 0);
    }
}

__device__ __forceinline__ void rope_table(const int* pos, float* tab, int gtid, int nthr) {
    for (int idx = gtid; idx < TT * 32; idx += nthr) {
        const int t = idx >> 5, i = idx & 31;
        double p = 1.0;
        for (int k = 0; k < i; ++k) p *= 1.333521432163324;
        const float inv = 1.0f / (float)p;
        const float ang = (float)pos[t] * inv;
        const double rev = (double)ang * 0.15915494309189535;
        const double fr = rev - rint(rev);
        const double q = rint(fr * 4.0);
        const float r = (float)((fr - q * 0.25) * 6.283185307179586);
        const float r2 = r * r;
        const float sn = r * (1.f + r2 * (-1.f / 6.f + r2 * (1.f / 120.f + r2 * (-1.f / 5040.f + r2 * (1.f / 362880.f)))));
        const float cs = 1.f + r2 * (-0.5f + r2 * (1.f / 24.f + r2 * (-1.f / 720.f + r2 * (1.f / 40320.f))));
        const int qi = ((int)q) & 3;
        const float c = (qi == 0) ? cs : (qi == 1) ? -sn : (qi == 2) ? -cs : sn;
        const float s = (qi == 0) ? sn : (qi == 1) ? cs : (qi == 2) ? -sn : -cs;
        tab[(size_t)t * 64 + i] = c; tab[(size_t)t * 64 + 32 + i] = s;
    }
}

struct NormJob { const float* xin; float* xout; const bf16* Y; const float* gpost; const float* gpre; bf16* XN; const float* gkv; bf16* XKV; const float* wg; const float* bg; float* G; };
__device__ __forceinline__ float softcap15(float z) { const float e = fexp(fminf(z * (2.f / 15.f), 80.f)); return 15.f * ((e - 1.f) / (e + 1.f)); }
__device__ __forceinline__ void norm_phase(const NormJob& J, LAS unsigned char* lds, int gw, int NGW, int tid, int lane) {
    LAS float* wl = (LAS float*)lds;
    if (J.wg) {
        for (int i = tid; i < 8192; i += NTHR) { const int d = i >> 3, q = i & 7; wl[q * 1024 + d] = J.wg[(size_t)d * MPROJ + q]; }
        __syncthreads();
    }
    constexpr int NR = 2;
    f32x4 nxv[2][NR][4]; v2u nyw[2][NR][4];
#pragma unroll
    for (int d = 0; d < 2; ++d)
#pragma unroll
        for (int r = 0; r < NR; ++r)
#pragma unroll
            for (int j = 0; j < 4; ++j) { nxv[d][r][j] = (f32x4){0.f, 0.f, 0.f, 0.f}; nyw[d][r][j] = (v2u){0u, 0u}; }
#pragma unroll
    for (int d = 0; d < 2; ++d) { const int mf = gw * NR + d * NGW * NR;
        if (mf < TT) {
#pragma unroll
            for (int r = 0; r < NR; ++r)
#pragma unroll
                for (int j = 0; j < 4; ++j) nxv[d][r][j] = __builtin_nontemporal_load((const f32x4*)(J.xin + (size_t)(mf + r) * DM) + lane + 64 * j);
            if (J.Y) {
#pragma unroll
                for (int r = 0; r < NR; ++r)
#pragma unroll
                    for (int j = 0; j < 4; ++j) nyw[d][r][j] = __builtin_nontemporal_load((const v2u*)(J.Y + (size_t)(mf + r) * DM) + lane + 64 * j); }
        } }
    for (int m0 = gw * NR; m0 < TT; m0 += NGW * NR) {
        f32x4 v[NR][4]; v2u yw[NR][4];
#pragma unroll
        for (int r = 0; r < NR; ++r)
#pragma unroll
            for (int j = 0; j < 4; ++j) { v[r][j] = nxv[0][r][j]; yw[r][j] = nyw[0][r][j]; nxv[0][r][j] = nxv[1][r][j]; nyw[0][r][j] = nyw[1][r][j]; }
        { const int m2 = m0 + 2 * NGW * NR;
          if (m2 < TT) {
#pragma unroll
            for (int r = 0; r < NR; ++r)
#pragma unroll
                for (int j = 0; j < 4; ++j) nxv[1][r][j] = __builtin_nontemporal_load((const f32x4*)(J.xin + (size_t)(m2 + r) * DM) + lane + 64 * j);
            if (J.Y) {
#pragma unroll
                for (int r = 0; r < NR; ++r)
#pragma unroll
                    for (int j = 0; j < 4; ++j) nyw[1][r][j] = __builtin_nontemporal_load((const v2u*)(J.Y + (size_t)(m2 + r) * DM) + lane + 64 * j); }
          } }
        if (J.Y) {
            float s[NR];
            f32x4 y[NR][4];
#pragma unroll
            for (int r = 0; r < NR; ++r) { s[r] = 0.f;
#pragma unroll
                for (int j = 0; j < 4; ++j) { const v2u w = yw[r][j]; y[r][j] = (f32x4){bflo(w.x), bfhi(w.x), bflo(w.y), bfhi(w.y)}; s[r] += (y[r][j].x * y[r][j].x + y[r][j].y * y[r][j].y) + (y[r][j].z * y[r][j].z + y[r][j].w * y[r][j].w); } }
#pragma unroll
            for (int o = 1; o < 64; o <<= 1) {
#pragma unroll
                for (int r = 0; r < NR; ++r) s[r] += shx(s[r], o, lane); }
#pragma unroll
            for (int r = 0; r < NR; ++r) { const float rr = rsqrtf(s[r] * (1.f / DM) + EPS);
                f32x4* xo = (f32x4*)(J.xout + (size_t)(m0 + r) * DM) + lane;
#pragma unroll
                for (int j = 0; j < 4; ++j) { const f32x4 gp = ((const f32x4*)J.gpost)[lane + 64 * j]; v[r][j] = v[r][j] + y[r][j] * rr * gp; __builtin_nontemporal_store(v[r][j], xo + 64 * j); } }
        }
        if (J.gpre) {
            float s2[NR];
#pragma unroll
            for (int r = 0; r < NR; ++r) { s2[r] = 0.f;
#pragma unroll
                for (int j = 0; j < 4; ++j) s2[r] += (v[r][j].x * v[r][j].x + v[r][j].y * v[r][j].y) + (v[r][j].z * v[r][j].z + v[r][j].w * v[r][j].w); }
#pragma unroll
            for (int o = 1; o < 64; o <<= 1) {
#pragma unroll
                for (int r = 0; r < NR; ++r) s2[r] += shx(s2[r], o, lane); }
#pragma unroll
            for (int r = 0; r < NR; ++r) { const int m = m0 + r;
                const float r2 = rsqrtf(s2[r] * (1.f / DM) + EPS);
                v2u* xn = (v2u*)(J.XN + (size_t)m * DM) + lane;
                f32x4 hn[4];
#pragma unroll
                for (int j = 0; j < 4; ++j) { const f32x4 g = ((const f32x4*)J.gpre)[lane + 64 * j]; hn[j] = v[r][j] * r2 * g; v2u w; w.x = pk2(hn[j].x, hn[j].y); w.y = pk2(hn[j].z, hn[j].w); xn[64 * j] = w; }
                if (J.gkv) {
                    v2u* xk = (v2u*)(J.XKV + (size_t)m * DM) + lane;
#pragma unroll
                    for (int j = 0; j < 4; ++j) { const f32x4 g = ((const f32x4*)J.gkv)[lane + 64 * j]; const f32x4 hk = v[r][j] * r2 * g; v2u w; w.x = pk2(hk.x, hk.y); w.y = pk2(hk.z, hk.w); xk[64 * j] = w; }
                }
                if (J.wg) {
                    float ga[8];
#pragma unroll
                    for (int q = 0; q < 8; ++q) { float sq = 0.f;
#pragma unroll
                        for (int j = 0; j < 4; ++j) { const f32x4 w = *(const LAS f32x4*)(wl + q * 1024 + 4 * lane + 256 * j); sq += (hn[j].x * w.x + hn[j].y * w.y) + (hn[j].z * w.z + hn[j].w * w.w); }
                        ga[q] = sq; }
#pragma unroll
                    for (int o = 1; o < 64; o <<= 1) {
#pragma unroll
                        for (int q = 0; q < 8; ++q) ga[q] += shx(ga[q], o, lane); }
                    const int q = lane & 7;
                    float z = (q == 0) ? ga[0] : (q == 1) ? ga[1] : (q == 2) ? ga[2] : (q == 3) ? ga[3] : (q == 4) ? ga[4] : (q == 5) ? ga[5] : (q == 6) ? ga[6] : ga[7];
                    z = softcap15(z + J.bg[q]);
                    if (q >= 4) z = fminf(z, 0.f) - __logf(1.f + fexp(-fabsf(z)));
                    if (lane < 8) J.G[(size_t)m * 8 + q] = z;
                }
            }
        }
    }
}

constexpr int VTP = 144;
constexpr int QP = 272;
constexpr int APP = 400;
constexpr int HSP = 260;

__device__ __forceinline__ unsigned elem16(const v4u& v, int i) { return (v[i >> 1] >> (16 * (i & 1))) & 0xffffu; }

__device__ __forceinline__ void m1_phase(LAS unsigned char* lds, const bf16* proj, const float* Gt, bf16* ST, float* dec, float* nst, int nblk, int bx, int tid, int lane, int wave) {
    LAS unsigned char* vT = lds; LAS unsigned char* kT = lds + 36864; LAS float* wsv = (LAS float*)(lds + 55296);
    const int fr = lane & 15, fg = lane >> 4, lp = tid & 31, pcg = tid >> 5;
    for (int unit = bx; unit < 2048; unit += nblk) {
        const int b = unit >> 10, h = (unit >> 8) & 3, c = unit & 255; const size_t t0 = (size_t)b * SEQ + (size_t)c * 64;
        if (wave == 0) {
            const float lf = Gt[(t0 + lane) * 8 + 4 + h], li = Gt[(t0 + lane) * 8 + h];
            float bs = lf;
#pragma unroll
            for (int o = 1; o < 64; o <<= 1) { const float t = shl_(bs, lane - o); if (lane >= o) bs += t; }
            const float bl = shl_(bs, 63);
            wsv[lane] = fexp(bl - bs + li) * KSCALE;
            if (lane == 63) dec[unit] = fexp(bl);
        }
        const bf16* r0 = proj + (t0 + 2 * lp) * NPROJ; const bf16* r1 = r0 + NPROJ;
        v4u va[2], vb[2];
#pragma unroll
        for (int n = 0; n < 2; ++n) { va[n] = *(const v4u*)(r0 + 1024 + h * 256 + 8 * (pcg + 16 * n)); vb[n] = *(const v4u*)(r1 + 1024 + h * 256 + 8 * (pcg + 16 * n)); }
        const v4u ka = *(const v4u*)(r0 + 512 + h * 128 + 8 * pcg), kb = *(const v4u*)(r1 + 512 + h * 128 + 8 * pcg);
        __syncthreads();
#pragma unroll
        for (int n = 0; n < 2; ++n)
#pragma unroll
            for (int i = 0; i < 8; ++i) *(LAS unsigned*)(vT + (8 * (pcg + 16 * n) + i) * VTP + lp * 4) = elem16(va[n], i) | (elem16(vb[n], i) << 16);
        const float w0 = wsv[2 * lp], w1 = wsv[2 * lp + 1];
#pragma unroll
        for (int i = 0; i < 8; ++i) *(LAS unsigned*)(kT + (8 * pcg + i) * VTP + lp * 4) = f2bf(__uint_as_float(elem16(ka, i) << 16) * w0) | (f2bf(__uint_as_float(elem16(kb, i) << 16) * w1) << 16);
        __syncthreads();
        f32x4 acc[2][8];
#pragma unroll
        for (int mt = 0; mt < 2; ++mt)
#pragma unroll
            for (int nt = 0; nt < 8; ++nt) acc[mt][nt] = (f32x4){0.f, 0.f, 0.f, 0.f};
#pragma unroll
        for (int ks = 0; ks < 2; ++ks) {
            bf16x8 vf[2];
#pragma unroll
            for (int mt = 0; mt < 2; ++mt) vf[mt] = *(const LAS bf16x8*)(vT + (32 * wave + 16 * mt + fr) * VTP + (32 * ks + 8 * fg) * 2);
#pragma unroll
            for (int nt = 0; nt < 8; ++nt) { const bf16x8 kf = *(const LAS bf16x8*)(kT + (16 * nt + fr) * VTP + (32 * ks + 8 * fg) * 2);
#pragma unroll
                for (int mt = 0; mt < 2; ++mt) acc[mt][nt] = MFMA16(kf, vf[mt], acc[mt][nt]); }
        }
        bf16* sp = ST + (size_t)unit * 32768;
        {
            LAS unsigned char* stg = lds + 57344 + wave * 8704;
#pragma unroll
            for (int mt = 0; mt < 2; ++mt)
#pragma unroll
                for (int nt = 0; nt < 8; ++nt) { v2u w; w.x = pk2(acc[mt][nt][0], acc[mt][nt][1]); w.y = pk2(acc[mt][nt][2], acc[mt][nt][3]);
                    *(LAS v2u*)(stg + (16 * mt + fr) * 272 + (16 * nt + 4 * fg) * 2) = w; }
#pragma unroll
            for (int i = 0; i < 8; ++i) { const int et = i >> 2, k2 = i & 3;
                const v4u v = *(const LAS v4u*)(stg + (16 * et + fr) * 272 + (32 * k2 + 8 * fg) * 2);
                *(v4u*)(sp + (size_t)((((wave * 2 + et) * 4 + k2) * 64 + lane) * 8)) = v; }
        }
        if (tid < 128) { float s = 0.f;
#pragma unroll
            for (int i = 0; i < 8; ++i) { const v4u w = *(const LAS v4u*)(kT + tid * VTP + i * 16);
#pragma unroll
                for (int e = 0; e < 4; ++e) s += bflo(w[e]) + bfhi(w[e]); }
            nst[(size_t)unit * 128 + tid] = s; }
        __syncthreads();
    }
}

__device__ __forceinline__ void m2_phase(bf16* ST, const float* dec, float* nst, int gtid, int nthr) {
    for (int chain = gtid; chain < 8 * 16384; chain += nthr) {
        const int bh = chain >> 14, idx = chain & 16383;
        unsigned* p = (unsigned*)ST + (size_t)bh * 256 * 16384 + idx; const float* dc = dec + bh * 256;
        float r0 = 0.f, r1 = 0.f;
        for (int c0 = 0; c0 < 256; c0 += 32) {
            unsigned v[32];
#pragma unroll
            for (int i = 0; i < 32; ++i) v[i] = p[(size_t)(c0 + i) * 16384];
#pragma unroll
            for (int i = 0; i < 32; ++i) { const float d = dc[c0 + i]; p[(size_t)(c0 + i) * 16384] = pk2(r0, r1); r0 = d * r0 + bflo(v[i]); r1 = d * r1 + bfhi(v[i]); }
        }
    }
    for (int chain = gtid; chain < 8 * 128; chain += nthr) {
        const int bh = chain >> 7, d = chain & 127;
        float* p = nst + (size_t)bh * 256 * 128 + d; const float* dc = dec + bh * 256;
        float r = 0.f;
        for (int c0 = 0; c0 < 256; c0 += 16) {
            float v[16];
#pragma unroll
            for (int i = 0; i < 16; ++i) v[i] = p[(c0 + i) * 128];
#pragma unroll
            for (int i = 0; i < 16; ++i) { const float dd = dc[c0 + i]; p[(c0 + i) * 128] = r; r = dd * r + v[i]; }
        }
    }
}

__device__ __forceinline__ void m3_phase(LAS unsigned char* lds, const bf16* proj, const float* Gt, const bf16* ST, const float* nst, const float* gh, bf16* YA, int nblk, int bx, int tid, int lane, int wave) {
    LAS unsigned char* qs = lds; LAS unsigned char* ksm = lds + 17408; LAS unsigned char* vT = lds + 34816; LAS unsigned char* Ap = lds + 71680;
    LAS float* bcs = (LAS float*)(lds + 97280); LAS float* lis = (LAS float*)(lds + 97536); LAS float* rsum = (LAS float*)(lds + 97792); LAS float* denq = (LAS float*)(lds + 98816);
    LAS float* Hs = (LAS float*)lds;
    const int fr = lane & 15, fg = lane >> 4, lp = tid & 31, pcg = tid >> 5;
    const int j2 = tid >> 3, part = tid & 7;
#define M3_LOAD(U, QV, KV, VA, VB, GLF, GLI) do { const int ub_ = (U) >> 10, uh_ = ((U) >> 8) & 3, uc_ = (U) & 255; const size_t ut0_ = (size_t)ub_ * SEQ + (size_t)uc_ * 64; \
        _Pragma("unroll") for (int n = 0; n < 2; ++n) { const int p = tid + 512 * n, row = p >> 4, pc = p & 15; const bf16* rp = proj + (ut0_ + row) * NPROJ + uh_ * 128 + 8 * pc; QV[n] = *(const v4u*)rp; KV[n] = *(const v4u*)(rp + 512); } \
        { const bf16* r0_ = proj + (ut0_ + 2 * lp) * NPROJ; const bf16* r1_ = r0_ + NPROJ; \
          _Pragma("unroll") for (int n = 0; n < 2; ++n) { VA[n] = *(const v4u*)(r0_ + 1024 + uh_ * 256 + 8 * (pcg + 16 * n)); VB[n] = *(const v4u*)(r1_ + 1024 + uh_ * 256 + 8 * (pcg + 16 * n)); } } \
        GLF = Gt[(ut0_ + lane) * 8 + 4 + uh_]; GLI = Gt[(ut0_ + lane) * 8 + uh_]; } while (0)
    v4u nqv[2], nkv[2], nva[2], nvb[2]; float nlf = 0.f, nli = 0.f;
#pragma unroll
    for (int n = 0; n < 2; ++n) { nqv[n] = (v4u){0u, 0u, 0u, 0u}; nkv[n] = nqv[n]; nva[n] = nqv[n]; nvb[n] = nqv[n]; }
    if (bx < 2048) M3_LOAD(bx, nqv, nkv, nva, nvb, nlf, nli);
    for (int unit = bx; unit < 2048; unit += nblk) {
        const int b = unit >> 10, h = (unit >> 8) & 3, c = unit & 255; const size_t t0 = (size_t)b * SEQ + (size_t)c * 64;
        v4u qv[2], kv[2], va[2], vb[2], cf[2][4], ovp[4]; f32x4 nv[4];
#pragma unroll
        for (int n = 0; n < 2; ++n) { qv[n] = nqv[n]; kv[n] = nkv[n]; va[n] = nva[n]; vb[n] = nvb[n]; }
        { const bf16* sp = ST + (size_t)unit * 32768;
#pragma unroll
            for (int et = 0; et < 2; ++et)
#pragma unroll
                for (int k2 = 0; k2 < 4; ++k2) cf[et][k2] = *(const v4u*)(sp + (size_t)((((wave * 2 + et) * 4 + k2) * 64 + lane) * 8)); }
#pragma unroll
        for (int i = 0; i < 4; ++i) { ovp[i] = *(const v4u*)(proj + (t0 + j2) * NPROJ + 2048 + h * 256 + 64 * i + 8 * part); nv[i] = *(const f32x4*)(nst + (size_t)unit * 128 + 16 * part + 4 * i); }
        if (wave == 0) {
            const float lf = nlf, li = nli;
            float bs = lf;
#pragma unroll
            for (int o = 1; o < 64; o <<= 1) { const float t = shl_(bs, lane - o); if (lane >= o) bs += t; }
            bcs[lane] = bs; lis[lane] = li;
        }
        __syncthreads();
#pragma unroll
        for (int n = 0; n < 2; ++n) { const int p = tid + 512 * n, row = p >> 4, pc = p & 15;
            *(LAS v4u*)(qs + row * QP + pc * 16) = qv[n]; *(LAS v4u*)(ksm + row * QP + pc * 16) = kv[n];
            const float eb = fexp(bcs[row]); v4u e;
#pragma unroll
            for (int w = 0; w < 4; ++w) e[w] = pk2(bflo(qv[n][w]) * eb, bfhi(qv[n][w]) * eb);
            *(LAS v4u*)(Ap + row * APP + 128 + pc * 16) = e; }
#pragma unroll
        for (int n = 0; n < 2; ++n)
#pragma unroll
            for (int i = 0; i < 8; ++i) *(LAS unsigned*)(vT + (8 * (pcg + 16 * n) + i) * VTP + lp * 4) = elem16(va[n], i) | (elem16(vb[n], i) << 16);
        { const int nu = unit + nblk; if (nu < 2048) M3_LOAD(nu, nqv, nkv, nva, nvb, nlf, nli); }
        __syncthreads();
        {
            const int jt = wave >> 1, j = 16 * jt + fr; const float bj = bcs[j];
#pragma unroll
            for (int sti = 0; sti < 2; ++sti) { const int st = 2 * (wave & 1) + sti;
                f32x4 acc = (f32x4){0.f, 0.f, 0.f, 0.f};
#pragma unroll
                for (int ks = 0; ks < 4; ++ks) { const bf16x8 kf = *(const LAS bf16x8*)(ksm + (16 * st + fr) * QP + (32 * ks + 8 * fg) * 2); const bf16x8 qf = *(const LAS bf16x8*)(qs + j * QP + (32 * ks + 8 * fg) * 2); acc = MFMA16(kf, qf, acc); }
                float val[4]; float rs = 0.f;
#pragma unroll
                for (int jj = 0; jj < 4; ++jj) { const int s = 16 * st + 4 * fg + jj; const float wgt = (s <= j) ? fexp(bj - bcs[s] + lis[s]) : 0.f; val[jj] = (s <= j) ? acc[jj] * KSCALE * wgt : 0.f; rs += val[jj]; }
                rs += shx(rs, 16, lane); rs += shx(rs, 32, lane);
                if (fg == 0) rsum[j * 4 + st] = rs;
                v2u w; w.x = pk2(val[0], val[1]); w.y = pk2(val[2], val[3]);
                *(LAS v2u*)(Ap + j * APP + (16 * st + 4 * fg) * 2) = w; }
        }
        {
            const v4u q0 = *(const LAS v4u*)(qs + j2 * QP + part * 32), q1 = *(const LAS v4u*)(qs + j2 * QP + part * 32 + 16);
            float s = 0.f;
#pragma unroll
            for (int w = 0; w < 4; ++w) { s += bflo(q0[w]) * nv[w >> 1][(2 * w) & 3] + bfhi(q0[w]) * nv[w >> 1][(2 * w + 1) & 3]; s += bflo(q1[w]) * nv[2 + (w >> 1)][(2 * w) & 3] + bfhi(q1[w]) * nv[2 + (w >> 1)][(2 * w + 1) & 3]; }
            s += shx(s, 1, lane); s += shx(s, 2, lane); s += shx(s, 4, lane);
            if (part == 0) denq[j2] = fexp(bcs[j2]) * s;
        }
        __syncthreads();
        f32x4 acc2[2][4];
#pragma unroll
        for (int et = 0; et < 2; ++et)
#pragma unroll
            for (int jt = 0; jt < 4; ++jt) acc2[et][jt] = (f32x4){0.f, 0.f, 0.f, 0.f};
#pragma unroll
        for (int ks = 0; ks < 6; ++ks) {
            bf16x8 af[2];
#pragma unroll
            for (int et = 0; et < 2; ++et) af[et] = (ks < 2) ? *(const LAS bf16x8*)(vT + (32 * wave + 16 * et + fr) * VTP + (32 * ks + 8 * fg) * 2) : __builtin_bit_cast(bf16x8, cf[et][(ks < 2) ? 0 : ks - 2]);
#pragma unroll
            for (int jt = 0; jt < 4; ++jt) { const bf16x8 bq = *(const LAS bf16x8*)(Ap + (16 * jt + fr) * APP + (32 * ks + 8 * fg) * 2);
#pragma unroll
                for (int et = 0; et < 2; ++et) acc2[et][jt] = MFMA16(af[et], bq, acc2[et][jt]); }
        }
        __syncthreads();
#pragma unroll
        for (int et = 0; et < 2; ++et)
#pragma unroll
            for (int jt = 0; jt < 4; ++jt) *(LAS f32x4*)(Hs + (16 * jt + fr) * HSP + 32 * wave + 16 * et + 4 * fg) = acc2[et][jt];
        __syncthreads();
        {
            const float den = (rsum[j2 * 4] + rsum[j2 * 4 + 1]) + (rsum[j2 * 4 + 2] + rsum[j2 * 4 + 3]) + denq[j2];
            const float inv = 1.f / fmaxf(fabsf(den), 1.f);
            float hv[4][8]; float ss = 0.f;
#pragma unroll
            for (int i = 0; i < 4; ++i) {
                const f32x4 h0 = *(const LAS f32x4*)(Hs + j2 * HSP + 64 * i + 8 * part) * inv, h1 = *(const LAS f32x4*)(Hs + j2 * HSP + 64 * i + 8 * part + 4) * inv;
                hv[i][0] = h0.x; hv[i][1] = h0.y; hv[i][2] = h0.z; hv[i][3] = h0.w; hv[i][4] = h1.x; hv[i][5] = h1.y; hv[i][6] = h1.z; hv[i][7] = h1.w;
#pragma unroll
                for (int u = 0; u < 8; ++u) ss += hv[i][u] * hv[i][u]; }
            ss += shx(ss, 1, lane); ss += shx(ss, 2, lane); ss += shx(ss, 4, lane);
            const float r = rsqrtf(ss * (1.f / 256.f) + EPS);
#pragma unroll
            for (int i = 0; i < 4; ++i) { const int e = 64 * i + 8 * part;
                const v4u ov = ovp[i];
                const f32x4 g0 = *(const f32x4*)(gh + h * 256 + e), g1 = *(const f32x4*)(gh + h * 256 + e + 4);
                const float gg[8] = {g0.x, g0.y, g0.z, g0.w, g1.x, g1.y, g1.z, g1.w};
                v4u o;
#pragma unroll
                for (int w = 0; w < 4; ++w) { const float x0 = hv[i][2 * w] * r * gg[2 * w], x1 = hv[i][2 * w + 1] * r * gg[2 * w + 1];
                    const float o0 = bflo(ov[w]), o1 = bfhi(ov[w]);
                    o[w] = pk2(x0 * __builtin_amdgcn_rcpf(1.f + fexp(-o0)), x1 * __builtin_amdgcn_rcpf(1.f + fexp(-o1))); }
                *(v4u*)(YA + (t0 + j2) * DM + h * 256 + e) = o; }
        }
        __syncthreads();
    }
}

#define XB_TMO      128
#define XB_XCNT(j)  (256  + 64 * (j))
#define XB_XSUB(j)  (1280 + 64 * (j))
#define XB_XGEN(j)  (2304 + 64 * (j))
#define XB_TOP      3328
#define XB_TOPGEN   3392
#define XCD_BAR_WORDS 3456
#define XB_SPIN_CAP (1u << 18)

__device__ __forceinline__ unsigned xb_ld(unsigned* p)              { return __hip_atomic_load(p, __ATOMIC_RELAXED, __HIP_MEMORY_SCOPE_AGENT); }
__device__ __forceinline__ unsigned xb_add(unsigned* p, unsigned v) { return __hip_atomic_fetch_add(p, v, __ATOMIC_RELAXED, __HIP_MEMORY_SCOPE_AGENT); }
__device__ __forceinline__ unsigned xb_xcc_id() { return (unsigned)__builtin_amdgcn_s_getreg((3 << 11) | 20) & 0xFu; }
#define XB_SPIN(cond, bar) do { unsigned _sp = 0; while (cond) { __builtin_amdgcn_s_sleep(1); \
    if ((++_sp & 255u) == 0u) { if (xb_ld(&(bar)[XB_TMO])) break; if (_sp > XB_SPIN_CAP) { atomicAdd(&(bar)[XB_TMO], 1u); break; } } } } while (0)

struct XcdBarrier {
    unsigned* bar; unsigned x;
    volatile LAS unsigned* st;
};

__device__ __forceinline__ XcdBarrier xcd_barrier_post(unsigned* bar, volatile LAS unsigned* st) {
    XcdBarrier b; b.bar = bar; b.x = xb_xcc_id(); b.st = st;
    if (threadIdx.x == 0) (void)xb_add(&bar[XB_XCNT(b.x)], 1u);
    return b;
}
__device__ __forceinline__ void xcd_barrier_complete(unsigned* bar, unsigned x, unsigned& nloc, unsigned& nx) {
    const unsigned G = gridDim.x * gridDim.y * gridDim.z;
    unsigned sum, cnt, mine, sp = 0u;
    for (;;) {
        sum = 0u; cnt = 0u; mine = 0u;
#pragma unroll
        for (unsigned j = 0; j < 16; ++j) { const unsigned c = xb_ld(&bar[XB_XCNT(j)]); sum += c; cnt += (c > 0u) ? 1u : 0u; mine = (j == x) ? c : mine; }
        if (sum == G) break;
        __builtin_amdgcn_s_sleep(1);
        if ((++sp & 255u) == 0u) { if (xb_ld(&bar[XB_TMO])) break; if (sp > XB_SPIN_CAP) { atomicAdd(&bar[XB_TMO], 1u); break; } }
    }
    nloc = mine > 0u ? mine : 1u; nx = cnt > 0u ? cnt : 1u;
}

__device__ __forceinline__ void xcd_barrier(const XcdBarrier& b) {
    asm volatile("s_waitcnt vmcnt(0)" ::: "memory");
    __syncthreads();
    if (threadIdx.x == 0) {
        unsigned* bar = b.bar; asm volatile("" : "+s"(bar));
        __builtin_amdgcn_s_waitcnt(0);
        unsigned nloc = b.st[0], nx = b.st[1];
        if (nloc == 0u) { xcd_barrier_complete(bar, b.x, nloc, nx); b.st[0] = nloc; b.st[1] = nx; }
        const unsigned old = xb_add(&bar[XB_XSUB(b.x)], 1u);
        const unsigned gen = old / nloc;
        if (old + 1u == (gen + 1u) * nloc) {
            __builtin_amdgcn_fence(__ATOMIC_RELEASE, "agent");
            asm volatile("s_waitcnt vmcnt(0)" ::: "memory");
            const unsigned og = xb_add(&bar[XB_TOP], 1u);
            const unsigned tg = og / nx;
            if (og + 1u == (tg + 1u) * nx) xb_add(&bar[XB_TOPGEN], 1u);
            else XB_SPIN(xb_ld(&bar[XB_TOPGEN]) == tg, bar);
            __builtin_amdgcn_fence(__ATOMIC_ACQUIRE, "agent");
            xb_add(&bar[XB_XGEN(b.x)], 1u);
            asm volatile("s_waitcnt vmcnt(0)" ::: "memory");
        } else {
            XB_SPIN(xb_ld(&bar[XB_XGEN(b.x)]) == gen, bar);
            __builtin_amdgcn_fence(__ATOMIC_ACQUIRE, "agent");
            asm volatile("s_waitcnt vmcnt(0)" ::: "memory");
        }
    }
    __syncthreads();
}

__global__ void __launch_bounds__(NTHR, 2) mk_fwd(Args a) {
    extern __shared__ __attribute__((aligned(16))) unsigned char lds_raw[];
    LAS unsigned char* lds = (LAS unsigned char*)lds_raw;
    const int ph_lo = __builtin_amdgcn_readfirstlane(a.ph_lo_), ph_hi = __builtin_amdgcn_readfirstlane(a.ph_hi_);
    for (int u = threadIdx.x; u < 16; u += NTHR) ((LAS unsigned*)(lds + LDS_BYTES - 64))[u] = 0u;
    __syncthreads();
    XcdBarrier xbar; xbar.bar = (unsigned*)a.ws + CW_BAR; xbar.x = xb_xcc_id(); xbar.st = (volatile LAS unsigned*)(lds + LDS_BYTES - 64);
    if (ph_hi - ph_lo > 1 && blockIdx.x == 0) { unsigned* bw = (unsigned*)a.ws + CW_BAR; for (int i = threadIdx.x; i < XCD_BAR_WORDS; i += NTHR) __hip_atomic_store(bw + i, 0u, __ATOMIC_RELAXED, __HIP_MEMORY_SCOPE_AGENT); }
    const int nblk = gridDim.x, NGW = nblk * NWAVES, nthr = nblk * NTHR;
    unsigned char* ws = a.ws;
    bf16* XN = (bf16*)(ws + WS_XN); bf16* PROJ = (bf16*)(ws + WS_PROJ); bf16* STb = (bf16*)(ws + WS_ST); bf16* YA = (bf16*)(ws + WS_YA);
    bf16* Qb = (bf16*)(ws + WS_Q); bf16* Kb = (bf16*)(ws + WS_K); bf16* Vb = (bf16*)(ws + WS_V); bf16* Ob = (bf16*)(ws + WS_O); bf16* Hb = (bf16*)(ws + WS_H);
    float* ROPE = (float*)(ws + WS_ROPE); float* Gt = (float*)(ws + WS_G); float* DEC = (float*)(ws + WS_DEC); float* NST = (float*)(ws + WS_NST);
    for (int ph = ph_lo; ph < ph_hi; ++ph) {
        if (ph > ph_lo) { if (ph == ph_lo + 1) { cg::this_grid().sync(); if (threadIdx.x == 0) (void)xb_add(&xbar.bar[XB_XCNT(xbar.x)], 1u); }   else xcd_barrier(xbar); }
        if (ph > 18 && (ph - 19) % 7 == 1) {
            int bxa = blockIdx.x; asm volatile("" : "+s"(bxa));
            const attn_body::AttnTensors AT{(const attn_body::bf16*)Qb, (const attn_body::bf16*)Kb, (const attn_body::bf16*)Vb, (attn_body::bf16*)Ob};
#ifndef NO_ATTN
            const int Lb = (ph - 19) / 7;
            const float* lam = a.b_lam + (size_t)Lb * 256; int tq = threadIdx.x; asm volatile("" : "+v"(tq)); const int ln = tq & 63;
            const float s01 = wave_sum(lam[ln] * lam[64 + ln], ln), s23 = wave_sum(lam[128 + ln] * lam[192 + ln], ln);
            const float lamf = __int_as_float(__builtin_amdgcn_readfirstlane(__float_as_int(fexp(s01) - fexp(s23) + a.lam_init[Lb])));
            const attn_body::Comb CB{(attn_body::bf16*)YA, a.b_g_head + (size_t)Lb * DM, lamf, a.lam_init[Lb]};
            attn_body::attn_phase<8>((char*)lds_raw, AT, CB, nblk, bxa);
#endif
            continue;
        }
        int tid_o = threadIdx.x, bx_o = blockIdx.x; asm volatile("" : "+v"(tid_o)); asm volatile("" : "+s"(bx_o));
        const int tid = tid_o, bx = bx_o, lane = tid & 63, wave = __builtin_amdgcn_readfirstlane(tid >> 6), gw = bx * NWAVES + wave, gtid = bx * NTHR + tid;
        if (ph == 0) {
            conv_weights(a, 0, lds, gw, NGW, wave, lane);
            rope_table(a.pos, ROPE, gtid, nthr);
            __syncthreads();
            NormJob J{a.x, nullptr, nullptr, nullptr, a.norm_g, XN, nullptr, nullptr, a.a_w_in + NPROJ, a.a_b_gates, Gt};
            norm_phase(J, lds, gw, NGW, tid, lane);
            continue;
        }
        int L, sub;
        if (ph <= 18) { L = (ph - 1) / 9; sub = (ph - 1) % 9; } else { const int q = ph - 19, sb = q % 7; L = 2 + q / 7; sub = sb + (sb >= 2 ? 2 : sb); }
        const bool isA = L < 2;
        if (sub == 0 || sub == 4 || sub == 6 || sub == 7) {
            const int ng = (sub == 0 && L == 2) ? 2 : 1;
            for (int gi = 0; gi < ng; ++gi) {
                pg8::Gemm g; pg8::EpiBf16 E; E.act = 0; E.split_cols = 0; E.split_stride = 0; E.scale0 = 1.f; E.rope = nullptr; E.rope_cols = 0;
                if (sub == 0) {
                    if (isA) { g = pg8::Gemm{XN, (const bf16*)(ws + WS_WA), TT, NPROJ, DM}; E.O = PROJ; E.ldc = NPROJ; }
                    else if (gi == 0) { g = pg8::Gemm{XN, (const bf16*)(ws + WS_WA), TT, DM, DM}; E.O = Qb; E.ldc = DM; E.split_cols = DM; E.scale0 = attn_body::C2; E.rope = ROPE; E.rope_cols = DM; }
                    else { g = pg8::Gemm{YA, (const bf16*)(ws + WS_WA) + (size_t)DM * DM, TT, 2 * DM, DM}; E.O = Kb; E.ldc = DM; E.split_cols = DM; E.split_stride = (WS_V - WS_K) / 2; E.rope = ROPE; E.rope_cols = DM; }
                } else if (sub == 4) { g = pg8::Gemm{YA, (const bf16*)(ws + WS_WO), TT, DM, DM}; E.O = XN; E.ldc = DM; }
                else if (sub == 6) { g = pg8::Gemm{XN, (const bf16*)(ws + WS_WU), TT, FF, DM}; E.O = Hb; E.ldc = FF; E.act = 2; }
                else { g = pg8::Gemm{Hb, (const bf16*)(ws + WS_WD), TT, DM, FF}; E.O = XN; E.ldc = DM; }
                pg8::StaticOrder S; S.init(g.M, g.N, nblk, bx);
#ifndef NO_GEMM
                for (int rp = 0; rp < PROBE_GEMM; ++rp) pg8::gemm_phase<pg8::EpiBf16, pg8::StaticOrder, true, true>(lds, g, S, E);
#endif
            }
        } else if (sub == 5 || sub == 8) {
            NormJob J{(L == 0 && sub == 5) ? a.x : a.out, a.out, XN, a.norm_g + (size_t)(L * 4 + (sub == 5 ? 1 : 3)) * DM, nullptr, XN, nullptr, nullptr, nullptr, nullptr, Gt};
            if (sub == 5) J.gpre = a.norm_g + (size_t)(L * 4 + 2) * DM;
            else if (L < 3) {
                conv_weights(a, L + 1, lds, gw, NGW, wave, lane);
                __syncthreads();
                J.gpre = a.norm_g + (size_t)((L + 1) * 4) * DM;
                if (L + 1 < 2) { J.wg = a.a_w_in + (size_t)(L + 1) * DM * MPROJ + NPROJ; J.bg = a.a_b_gates + (L + 1) * 8; }
                if (L + 1 == 2) { J.gkv = a.kv_norm_g; J.XKV = YA; }
            }
            norm_phase(J, lds, gw, NGW, tid, lane);
        } else if (isA) {
#ifndef NO_M
            if (sub == 1) for (int rp = 0; rp < PROBE_M; ++rp) m1_phase(lds, PROJ, Gt, STb, DEC, NST, nblk, bx, tid, lane, wave);
            else if (sub == 2) m2_phase(STb, DEC, NST, gtid, nthr);
            else for (int rp = 0; rp < PROBE_M; ++rp) m3_phase(lds, PROJ, Gt, STb, NST, a.a_g_head + (size_t)L * DM, YA, nblk, bx, tid, lane, wave);
#endif
        } else {
        }
    }
}

extern "C" void kernel_launch(void* const* d_in, const int* in_sizes, int n_in, void* d_out, int out_size, void* d_ws, size_t ws_size, hipStream_t stream) {
    static int grid = 0;
    if (grid == 0) {
        if (n_in != 15 || in_sizes[0] != TT * DM || out_size != TT * DM || ws_size < WS_END) { fprintf(stderr, "kernel_launch: unexpected shapes / workspace (n_in %d, in0 %d, out %d, ws %zu); nothing launched\n", n_in, n_in > 0 ? in_sizes[0] : -1, out_size, ws_size); grid = -1; return; }
        int dev = 0, cus = 0, per_cu = 0;
        if (hipGetDevice(&dev) != hipSuccess || hipDeviceGetAttribute(&cus, hipDeviceAttributeMultiprocessorCount, dev) != hipSuccess) { grid = -1; return; }
        if (hipFuncSetAttribute((const void*)mk_fwd, hipFuncAttributeMaxDynamicSharedMemorySize, LDS_BYTES) != hipSuccess) { fprintf(stderr, "kernel_launch: hipFuncSetAttribute failed\n"); grid = -1; return; }
        if (hipOccupancyMaxActiveBlocksPerMultiprocessor(&per_cu, (const void*)mk_fwd, NTHR, LDS_BYTES) != hipSuccess || per_cu < 1) per_cu = 1;
        (void)hipGetLastError();
        grid = cus * per_cu;
    }
    if (grid < 0) return;
    Args a{};
    a.x = (const float*)d_in[0]; a.pos = (const int*)d_in[1]; a.norm_g = (const float*)d_in[2]; a.a_w_in = (const float*)d_in[3]; a.a_b_gates = (const float*)d_in[4];
    a.a_g_head = (const float*)d_in[5]; a.a_w_out = (const float*)d_in[6]; a.kv_norm_g = (const float*)d_in[7]; a.w_kv = (const float*)d_in[8]; a.b_w_q = (const float*)d_in[9];
    a.b_lam = (const float*)d_in[10]; a.b_g_head = (const float*)d_in[11]; a.b_w_out = (const float*)d_in[12]; a.mlp_up = (const float*)d_in[13]; a.mlp_down = (const float*)d_in[14];
    a.out = (float*)d_out; a.ws = (unsigned char*)d_ws;
    a.lam_init[0] = (float)(0.8 - 0.6 * exp(-0.3 * 2.0)); a.lam_init[1] = (float)(0.8 - 0.6 * exp(-0.3 * 3.0));
#if MK_MULTI
    for (int ph = 0; ph < NPH; ++ph) { a.ph_lo_ = ph; a.ph_hi_ = ph + 1; hipLaunchKernelGGL(mk_fwd, dim3(grid), dim3(NTHR), LDS_BYTES, stream, a); }
#else
    a.ph_lo_ = 0; a.ph_hi_ = NPH;
    void* args[] = {&a};
    hipError_t e = hipLaunchCooperativeKernel((const void*)mk_fwd, dim3(grid), dim3(NTHR), args, LDS_BYTES, stream);
    if (e != hipSuccess) fprintf(stderr, "cooperative launch failed: %s (grid %d)\n", hipGetErrorString(e), grid);
#endif
}
```

```cpp
#include <hip/hip_runtime.h>
#include <hip/hip_cooperative_groups.h>
#include <cstdio>
#include <cstdint>
#include <cmath>
namespace pg8 {
#define PG8_LAS __attribute__((address_space(3)))
typedef unsigned short bf16_t;
typedef short bf16x8 __attribute__((ext_vector_type(8)));
typedef float f32x4 __attribute__((ext_vector_type(4)));
typedef unsigned u32x4 __attribute__((ext_vector_type(4)));
constexpr int BM = 256, BK = 64, HALF = 128, HTB = HALF * BK * 2  , STAGE_BYTES = 8 * HTB, NXCD = 8, WGM = 8;

__host__ __device__ __forceinline__ int lds_byte(int r, int c) { const int st = (r >> 4) * 2 + (c >> 5), rr = r & 15, cc = c & 31, ob = rr * 64 + cc * 2; return st * 1024 + (ob ^ (((ob >> 9) & 1) << 5)); }
__host__ __device__ __forceinline__ void stage_rc(int b, int& R, int& C) { const int st = b / 1024, sb = b % 1024, swz = sb ^ (((sb >> 9) & 1) << 5); R = (st >> 1) * 16 + swz / 64; C = (st & 1) * 32 + (swz % 64) / 2; }
__host__ __device__ __forceinline__ int perm32(int rho) { const int n = rho >> 4, i = rho & 15; return 8 * (i >> 2) + 4 * n + (i & 3); }

struct Unit { int pm, pn; };
struct Gemm { const bf16_t* A; const bf16_t* Bt; int M, N, K; };

struct StaticOrder {
    int nM, nN, nwg, G, c;
    __host__ __device__ void init(int M, int N, int G_, int c_) { nM = M / BM; nN = N / BM; nwg = nM * nN; G = G_; c = c_; }
    __host__ __device__ bool next(int i, Unit& u) const {
        const long L = (long)i * G + c; if (L >= nwg) return false;
        int wgid = (int)L; { const int q = nwg / NXCD, r = nwg % NXCD, xcd = wgid % NXCD, off = wgid / NXCD; wgid = (xcd < r ? xcd * (q + 1) : r * (q + 1) + (xcd - r) * q) + off; }
        const int nig = WGM * nN, gid = wgid / nig, fm = gid * WGM, gsz = (nM - fm) < WGM ? (nM - fm) : WGM;
        u.pm = fm + ((wgid % nig) % gsz); u.pn = (wgid % nig) / gsz; return true;
    }
    __device__ __forceinline__ void a_ready(const Unit&) const {}
    __device__ __forceinline__ void done(const Unit&) const {}
};

__device__ __forceinline__ unsigned cvt_pk_bf16(float lo, float hi) { unsigned r; asm volatile("v_cvt_pk_bf16_f32 %0, %1, %2" : "=v"(r) : "v"(lo), "v"(hi)); return r; }
typedef float f32x2 __attribute__((ext_vector_type(2)));
struct EpiBf16 {
    static constexpr bool PERM = true, AFTER_DRAIN = false;
    bf16_t* O; int ldc; int act; int split_cols; size_t split_stride; float scale0; const float* rope; int rope_cols;
    __device__ __forceinline__ void operator()(const f32x4 (&acc)[2][2][4][2], const Unit& u, int wr, int wc, int fr, int fq) const {
        const int row0 = u.pm * BM + wr * 64 + fr; int colt = u.pn * BM; bf16_t* base = O;
        float sc = 1.f; if (split_cols) { const int t = colt / split_cols; base += (size_t)t * split_stride; colt -= t * split_cols; if (t == 0) sc = scale0; }
        const int col0 = colt + wc * 32 + 8 * fq;
        if (rope != nullptr && u.pn * BM < rope_cols) {
            typedef unsigned u32x2 __attribute__((ext_vector_type(2)));
#pragma unroll
            for (int ai = 0; ai < 2; ++ai)
#pragma unroll
                for (int m = 0; m < 4; ++m) { const size_t row = (size_t)(row0 + ai * HALF + m * 16);
#pragma unroll
                    for (int bj = 0; bj < 2; ++bj) { const int gc = col0 + bj * HALF, hd6 = gc & ~63, m4 = ((gc & 63) >> 3) * 4;
                        const float* tp = rope + row * 64 + m4; const f32x4 cs = *(const f32x4*)tp, sn = *(const f32x4*)(tp + 32);
                        const f32x4 v0 = acc[ai][bj][m][0], v1 = acc[ai][bj][m][1];
                        const f32x4 o1 = (v0 * cs - v1 * sn) * sc, o2 = (v1 * cs + v0 * sn) * sc;
                        u32x2 w1, w2; w1.x = cvt_pk_bf16(o1[0], o1[1]); w1.y = cvt_pk_bf16(o1[2], o1[3]); w2.x = cvt_pk_bf16(o2[0], o2[1]); w2.y = cvt_pk_bf16(o2[2], o2[3]);
                        bf16_t* rp = base + row * ldc + hd6 + m4; *(u32x2*)rp = w1; *(u32x2*)(rp + 32) = w2; } }
            return;
        }
#pragma unroll
        for (int ai = 0; ai < 2; ++ai)
#pragma unroll
            for (int m = 0; m < 4; ++m) { bf16_t* rowp = base + (size_t)(row0 + ai * HALF + m * 16) * ldc + col0;
#pragma unroll
                for (int bj = 0; bj < 2; ++bj) { f32x4 v0 = acc[ai][bj][m][0], v1 = acc[ai][bj][m][1];
                    if (act == 2) {
#pragma unroll
                        for (int e = 0; e < 4; ++e) { const float a0 = fmaxf(v0[e], 0.f), a1 = fmaxf(v1[e], 0.f); v0[e] = a0 * a0; v1[e] = a1 * a1; } }
                    v0 = v0 * sc; v1 = v1 * sc; u32x4 w; w.x = cvt_pk_bf16(v0[0], v0[1]); w.y = cvt_pk_bf16(v0[2], v0[3]); w.z = cvt_pk_bf16(v1[0], v1[1]); w.w = cvt_pk_bf16(v1[2], v1[3]);
                    *(u32x4*)(rowp + bj * HALF) = w; } }
    }
};

template <class Epi, class Sched, bool ALIGN_EPI = false, bool SP2 = false>
__device__ __forceinline__ void gemm_phase(PG8_LAS unsigned char* lds, const Gemm g, const Sched& S, const Epi& E) {
    int tid_o = threadIdx.x; asm volatile("" : "+v"(tid_o));
    const int tid = tid_o, wid = __builtin_amdgcn_readfirstlane(tid >> 6), lane = tid & 63, wr = wid >> 2, wc = wid & 3, fr = lane & 15, fq = lane >> 4;
    const int K = g.K, nt = K / BK;
    unsigned voffA[2], voffB[2];
#pragma unroll
    for (int i = 0; i < 2; ++i) { int R, C; stage_rc(tid * 16 + i * 8192, R, C); const int Rb = Epi::PERM ? ((R & ~31) + perm32(R & 31)) : R;
        voffA[i] = (unsigned)(R * K + C) * 2u; voffB[i] = (unsigned)(Rb * K + C) * 2u; }
    const size_t kstep = (size_t)(BK * 2);
    const size_t hstep = (size_t)HALF * K * 2;
    const size_t tstep = 2 * hstep;
    const unsigned ldsw = (unsigned)wid * 1024u;
    const int aoff = lds_byte(wr * 64 + fr, fq * 8), boff = lds_byte(wc * 32 + fr, fq * 8);
#define PG8_SA(b, h) (((b) * 2 + (h)) * HTB)
#define PG8_SB(b, h) ((4 + (b) * 2 + (h)) * HTB)
#define PG8_STAGE(bufoff, gbase, voff) do { _Pragma("unroll") for (int _i = 0; _i < 2; ++_i) \
        __builtin_amdgcn_global_load_lds((const unsigned*)((const char*)(gbase) + (voff)[_i]), (PG8_LAS unsigned*)(lds + (bufoff) + ldsw + _i * 8192), 16, 0, 0); } while (0)
#define PG8_LDA(dst, b, h) do { _Pragma("unroll") for (int m = 0; m < 4; ++m) _Pragma("unroll") for (int k = 0; k < 2; ++k) dst[m][k] = *(const PG8_LAS bf16x8*)(lds + PG8_SA(b, h) + aoff + m * 2048 + k * 1024); } while (0)
#define PG8_LDB(dst, b, h) do { _Pragma("unroll") for (int n = 0; n < 2; ++n) _Pragma("unroll") for (int k = 0; k < 2; ++k) dst[n][k] = *(const PG8_LAS bf16x8*)(lds + PG8_SB(b, h) + boff + n * 2048 + k * 1024); } while (0)
#define PG8_MMA(ai, bj, At, Bt) do { __builtin_amdgcn_s_setprio(1); _Pragma("unroll") for (int m = 0; m < 4; ++m) _Pragma("unroll") for (int n = 0; n < 2; ++n) _Pragma("unroll") for (int k = 0; k < 2; ++k) \
        acc[ai][bj][m][n] = __builtin_amdgcn_mfma_f32_16x16x32_bf16(Bt[n][k], At[m][k], acc[ai][bj][m][n], 0, 0, 0); __builtin_amdgcn_s_setprio(0); } while (0)
#define PG8_WAIT_V(n) asm volatile("s_waitcnt vmcnt(" #n ")" ::: "memory")
#define PG8_WAIT_L(n) asm volatile("s_waitcnt lgkmcnt(" #n ")" ::: "memory")
#define PG8_BAR __builtin_amdgcn_s_barrier()
#define PG8_SCHED __builtin_amdgcn_sched_barrier(0)
    Unit cur, nxt; int ui = 0;
    if (!S.next(0, cur)) return;
    f32x4 acc[2][2][4][2];
#pragma unroll
    for (int a = 0; a < 2; ++a)
#pragma unroll
        for (int b = 0; b < 2; ++b)
#pragma unroll
            for (int m = 0; m < 4; ++m)
#pragma unroll
                for (int n = 0; n < 2; ++n) acc[a][b][m][n] = (f32x4){0.f, 0.f, 0.f, 0.f};
    bf16x8 At[4][2], B0[2][2], B1[2][2];
    const char* cA = (const char*)g.A + (size_t)cur.pm * tstep; const char* cB = (const char*)g.Bt + (size_t)cur.pn * tstep;
    S.a_ready(cur);
    if constexpr (SP2) {
        PG8_STAGE(PG8_SB(0, 0), cB, voffB); PG8_STAGE(PG8_SB(0, 1), cB + hstep, voffB); PG8_STAGE(PG8_SA(0, 0), cA, voffA); PG8_STAGE(PG8_SA(0, 1), cA + hstep, voffA);
        if (wr == 1) PG8_BAR;
        PG8_WAIT_V(2); PG8_BAR;
        PG8_STAGE(PG8_SB(1, 0), cB + kstep, voffB); PG8_STAGE(PG8_SA(1, 0), cA + kstep, voffA); PG8_STAGE(PG8_SB(1, 1), cB + hstep + kstep, voffB);
        PG8_WAIT_V(6); PG8_BAR;
    } else {
        PG8_STAGE(PG8_SB(0, 0), cB, voffB); PG8_STAGE(PG8_SA(0, 0), cA, voffA); PG8_STAGE(PG8_SB(0, 1), cB + hstep, voffB); PG8_STAGE(PG8_SA(0, 1), cA + hstep, voffA);
        if (wr == 1) PG8_BAR;
        PG8_WAIT_V(4); PG8_BAR;
        PG8_STAGE(PG8_SB(1, 0), cB + kstep, voffB); PG8_STAGE(PG8_SA(1, 0), cA + kstep, voffA); PG8_STAGE(PG8_SB(1, 1), cB + hstep + kstep, voffB);
        PG8_WAIT_V(6); PG8_BAR;
    }
    for (;;) {
        const bool has_next = S.next(ui + 1, nxt);
        const char* nA = has_next ? (const char*)g.A + (size_t)nxt.pm * tstep : cA; const char* nB = has_next ? (const char*)g.Bt + (size_t)nxt.pn * tstep : cB;
        for (int t = 0; t < nt; t += 2) {
            const bool last = (t == nt - 2);
            const char* a1 = cA + (size_t)(t + 1) * kstep;
            const char* a2 = last ? nA : cA + (size_t)(t + 2) * kstep; const char* b2 = last ? nB : cB + (size_t)(t + 2) * kstep;
            const char* a3 = a2 + kstep; const char* b3 = b2 + kstep;
            if (last && has_next) S.a_ready(nxt);
            if constexpr (SP2) {
            PG8_LDB(B0, 0, 0); PG8_LDB(B1, 0, 1); PG8_SCHED; PG8_LDA(At, 0, 0); PG8_STAGE(PG8_SA(1, 1), a1 + hstep, voffA);
            PG8_WAIT_V(8); PG8_WAIT_L(0); PG8_BAR; PG8_MMA(0, 0, At, B0); PG8_MMA(0, 1, At, B1); PG8_BAR; PG8_SCHED;
            PG8_LDA(At, 0, 1); PG8_STAGE(PG8_SB(0, 0), b2, voffB); PG8_STAGE(PG8_SB(0, 1), b2 + hstep, voffB); PG8_STAGE(PG8_SA(0, 0), a2, voffA);
            PG8_WAIT_V(8); PG8_WAIT_L(0); PG8_BAR; PG8_MMA(1, 0, At, B0); PG8_MMA(1, 1, At, B1); PG8_BAR; PG8_SCHED;
            PG8_LDB(B0, 1, 0); PG8_LDB(B1, 1, 1); PG8_SCHED; PG8_LDA(At, 1, 0); PG8_STAGE(PG8_SA(0, 1), a2 + hstep, voffA);
            PG8_WAIT_V(8); PG8_WAIT_L(0); PG8_BAR; PG8_MMA(0, 0, At, B0); PG8_MMA(0, 1, At, B1); PG8_BAR; PG8_SCHED;
            PG8_LDA(At, 1, 1); PG8_STAGE(PG8_SB(1, 0), b3, voffB); PG8_STAGE(PG8_SB(1, 1), b3 + hstep, voffB); PG8_STAGE(PG8_SA(1, 0), a3, voffA);
            PG8_WAIT_V(8); PG8_WAIT_L(0); PG8_BAR; PG8_MMA(1, 0, At, B0); PG8_MMA(1, 1, At, B1); PG8_BAR; PG8_SCHED;
            } else {
            PG8_LDB(B0, 0, 0); PG8_SCHED; PG8_LDA(At, 0, 0); PG8_STAGE(PG8_SA(1, 1), a1 + hstep, voffA);
            PG8_WAIT_L(8); PG8_BAR; PG8_WAIT_L(0); PG8_MMA(0, 0, At, B0); PG8_BAR; PG8_SCHED;
            PG8_LDB(B1, 0, 1); PG8_STAGE(PG8_SB(0, 0), b2, voffB);
            PG8_BAR; PG8_WAIT_L(0); PG8_MMA(0, 1, At, B1); PG8_BAR;
            PG8_LDA(At, 0, 1); PG8_STAGE(PG8_SA(0, 0), a2, voffA);
            PG8_BAR; PG8_WAIT_L(0); PG8_MMA(1, 0, At, B0); PG8_BAR; PG8_SCHED;
            PG8_STAGE(PG8_SB(0, 1), b2 + hstep, voffB);
            PG8_WAIT_V(6); PG8_BAR; PG8_MMA(1, 1, At, B1); PG8_BAR;
            PG8_LDB(B0, 1, 0); PG8_SCHED; PG8_LDA(At, 1, 0); PG8_STAGE(PG8_SA(0, 1), a2 + hstep, voffA);
            PG8_WAIT_L(8); PG8_BAR; PG8_WAIT_L(0); PG8_MMA(0, 0, At, B0); PG8_BAR; PG8_SCHED;
            PG8_LDB(B1, 1, 1); PG8_STAGE(PG8_SB(1, 0), b3, voffB);
            PG8_BAR; PG8_WAIT_L(0); PG8_MMA(0, 1, At, B1); PG8_BAR;
            PG8_LDA(At, 1, 1); PG8_STAGE(PG8_SA(1, 0), a3, voffA);
            PG8_BAR; PG8_WAIT_L(0); PG8_MMA(1, 0, At, B0); PG8_BAR; PG8_SCHED;
            PG8_STAGE(PG8_SB(1, 1), b3 + hstep, voffB);
            PG8_WAIT_V(6); PG8_BAR; PG8_MMA(1, 1, At, B1); PG8_BAR;
            }
        }
        if constexpr (ALIGN_EPI) { if (wr == 0) PG8_BAR; }
        if constexpr (!Epi::AFTER_DRAIN) { E(acc, cur, wr, wc, fr, fq); S.done(cur); }
        if (!has_next) break;
#pragma unroll
        for (int a = 0; a < 2; ++a)
#pragma unroll
            for (int b = 0; b < 2; ++b)
#pragma unroll
                for (int m = 0; m < 4; ++m)
#pragma unroll
                    for (int n = 0; n < 2; ++n) acc[a][b][m][n] = (f32x4){0.f, 0.f, 0.f, 0.f};
        cur = nxt; cA = nA; cB = nB; ++ui;
        if constexpr (ALIGN_EPI) { if (wr == 1) PG8_BAR; }
    }
    PG8_WAIT_V(0);
    if constexpr (!ALIGN_EPI) { if (wr == 0) PG8_BAR; }
    PG8_BAR;
    if constexpr (Epi::AFTER_DRAIN) { E.fused(acc, cur, wr, wc, fr, fq, lds, wid, lane); S.done(cur); }
#undef PG8_SA
#undef PG8_SB
#undef PG8_STAGE
#undef PG8_LDA
#undef PG8_LDB
#undef PG8_MMA
#undef PG8_WAIT_V
#undef PG8_WAIT_L
#undef PG8_BAR
#undef PG8_SCHED
}
}

#include <hip/hip_bf16.h>
#include <cmath>
namespace attn_body {
using bf16=__hip_bfloat16;
using bf16x8=__attribute__((ext_vector_type(8)))short;
using s16x4=__attribute__((ext_vector_type(4)))short;
using f32x16=__attribute__((ext_vector_type(16)))float;
using u32x4=__attribute__((ext_vector_type(4)))unsigned;
constexpr int BATCH=2,NHEAD=16,SEQ=16384,D=64,DM=NHEAD*D,OPITCH=2048;
constexpr int NW=8,QBLK=32,QB=QBLK*NW,KVBLK=64,NQB=SEQ/QB;
constexpr int ATTN_PITCH=DM, ATTN_UNIT_ROWS=QB;
__device__ __forceinline__ int crow(int r,int hi){return (r&3)+8*(r>>2)+4*hi;}
#define SBAR() __builtin_amdgcn_sched_barrier(0)
__device__ __forceinline__ void cmask(f32x16&p0,f32x16&p1,int jb,int qrel,int hi){
  const float NEG=-INFINITY; int kb=64*jb+4*hi;
  #pragma unroll
  for(int r=0;r<16;++r){int kv=kb+(r&3)+8*(r>>2); if(kv>qrel)p0[r]=NEG; if(kv+32>qrel)p1[r]=NEG;}
}

constexpr int NSLOT=3, SLOTB=8192;
constexpr int LDS_K=0, LDS_V=NSLOT*SLOTB, LDS_V2=2*NSLOT*SLOTB, LDS_WS=3*NSLOT*SLOTB, LDS_OST=LDS_WS+NW*64*4, LDS_BYTES=LDS_OST+NW*8192;
constexpr float C2=0.125f*1.4426950408889634f;
__device__ __forceinline__ void glds16(const void*gsrc,unsigned lds_dst){unsigned keep;
  asm volatile("s_mov_b32 %0, m0\n\ts_mov_b32 m0, %2\n\ts_nop 0\n\tglobal_load_lds_dwordx4 %1, off\n\ts_mov_b32 m0, %0":"=&s"(keep):"v"(gsrc),"s"(lds_dst):"memory");}
__device__ __forceinline__ float max3f(float a,float b,float c){float r;asm("v_max3_f32 %0, %1, %2, %3":"=v"(r):"v"(a),"v"(b),"v"(c));return r;}
__device__ __forceinline__ float max2f(float a,float b){float r;asm("v_max_f32_e32 %0, %1, %2":"=v"(r):"v"(a),"v"(b));return r;}
__device__ __forceinline__ float fadd_s(float a,float b){float r;asm("v_add_f32_e32 %0, %1, %2":"=v"(r):"v"(a),"v"(b));return r;}
__device__ __forceinline__ float fsub_s(float a,float b){float r;asm("v_sub_f32_e32 %0, %1, %2":"=v"(r):"v"(a),"v"(b));return r;}
typedef float f32x2_t __attribute__((ext_vector_type(2))); typedef __bf16 bf16x2_t __attribute__((ext_vector_type(2)));
__device__ __forceinline__ unsigned cvtpk_s(float lo,float hi){f32x2_t v={lo,hi};bf16x2_t b=__builtin_convertvector(v,bf16x2_t);return __builtin_bit_cast(unsigned,b);}
#define WAIT_BAR(N) asm volatile("s_waitcnt vmcnt(" #N ") lgkmcnt(0)\n\ts_barrier":::"memory")

__device__ __forceinline__ void qkt(f32x16&p0,f32x16&p1,const char*Kslot,const bf16x8*qr,const f32x16&negm,int r32,int hi){
  const char*kb=Kslot+hi*1024+r32*16;
  #pragma unroll
  for(int d0=0;d0<4;++d0){
    const bf16x8 b0=*reinterpret_cast<const bf16x8*>(kb+d0*2048);
    const bf16x8 b1=*reinterpret_cast<const bf16x8*>(kb+d0*2048+512);
    if(d0==0){p0=__builtin_amdgcn_mfma_f32_32x32x16_bf16(b0,qr[0],negm,0,0,0);p1=__builtin_amdgcn_mfma_f32_32x32x16_bf16(b1,qr[0],negm,0,0,0);}
    else{p0=__builtin_amdgcn_mfma_f32_32x32x16_bf16(b0,qr[d0],p0,0,0,0);p1=__builtin_amdgcn_mfma_f32_32x32x16_bf16(b1,qr[d0],p1,0,0,0);}}
}
typedef __attribute__((address_space(3))) const char* lds_cptr;
typedef short v4i16_t __attribute__((ext_vector_type(4)));
__device__ __forceinline__ void kload8(bf16x8*kf,lds_cptr kp){
  kf[0]=*(const __attribute__((address_space(3))) bf16x8*)(kp);      kf[1]=*(const __attribute__((address_space(3))) bf16x8*)(kp+512);
  kf[2]=*(const __attribute__((address_space(3))) bf16x8*)(kp+2048); kf[3]=*(const __attribute__((address_space(3))) bf16x8*)(kp+2560);
  kf[4]=*(const __attribute__((address_space(3))) bf16x8*)(kp+4096); kf[5]=*(const __attribute__((address_space(3))) bf16x8*)(kp+4608);
  kf[6]=*(const __attribute__((address_space(3))) bf16x8*)(kp+6144); kf[7]=*(const __attribute__((address_space(3))) bf16x8*)(kp+6656);
}
__device__ __forceinline__ void kload2(bf16x8*kf,lds_cptr kp,int j){ kf[2*j]=*(const __attribute__((address_space(3))) bf16x8*)(kp+j*2048); kf[2*j+1]=*(const __attribute__((address_space(3))) bf16x8*)(kp+j*2048+512); }
__device__ __forceinline__ s16x4 vtr(lds_cptr p){ return __builtin_bit_cast(s16x4,__builtin_amdgcn_ds_read_tr16_b64_v4i16((__attribute__((address_space(3))) v4i16_t*)p)); }
__device__ __forceinline__ float rowmax(const f32x16&p0,const f32x16&p1){
  float a=max3f(p0[0],p0[1],p1[0]),b=max3f(p0[2],p0[3],p1[1]);a=max3f(a,p1[2],p1[3]);
  #pragma unroll
  for(int r=4;r<16;r+=4){a=max3f(a,p0[r],p0[r+1]);b=max3f(b,p0[r+2],p0[r+3]);a=max3f(a,p1[r],p1[r+1]);b=max3f(b,p1[r+2],p1[r+3]);}
  const float m=max2f(a,b);
  auto rr=__builtin_amdgcn_permlane32_swap(__float_as_uint(m),__float_as_uint(m),false,false);
  return max2f(__uint_as_float(rr[0]),__uint_as_float(rr[1]));
}
__device__ __forceinline__ void pv(f32x16*o,int vb,bf16x8 pa0,bf16x8 pa1,bf16x8 pa2,bf16x8 pa3){
  #pragma unroll
  for(int d0=0;d0<2;++d0){s16x4 lo[4],hi[4];
    #pragma unroll
    for(int ks=0;ks<4;++ks){
      asm volatile("ds_read_b64_tr_b16 %0,%1 offset:%c2":"=&v"(lo[ks]):"v"(vb),"i"(d0*4096+ks*1024):"memory");
      asm volatile("ds_read_b64_tr_b16 %0,%1 offset:%c2":"=&v"(hi[ks]):"v"(vb),"i"(d0*4096+ks*1024+512):"memory");}
    asm volatile("s_waitcnt lgkmcnt(0)":::"memory");SBAR();
    #define PK(k) (bf16x8){lo[k][0],lo[k][1],lo[k][2],lo[k][3],hi[k][0],hi[k][1],hi[k][2],hi[k][3]}
    o[d0]=__builtin_amdgcn_mfma_f32_32x32x16_bf16(pa0,PK(0),o[d0],0,0,0);
    o[d0]=__builtin_amdgcn_mfma_f32_32x32x16_bf16(pa1,PK(1),o[d0],0,0,0);
    o[d0]=__builtin_amdgcn_mfma_f32_32x32x16_bf16(pa2,PK(2),o[d0],0,0,0);
    o[d0]=__builtin_amdgcn_mfma_f32_32x32x16_bf16(pa3,PK(3),o[d0],0,0,0);
    #undef PK
  }
}

#ifndef ATTN_STORE16
#define ATTN_STORE16(p,v) (*(u32x4*)(p)=(v))
#endif
struct Comb { bf16* XA; const float* gh; float lamf, lam_init; };
template<int THRL> __device__ __forceinline__ void attn_unit(int b,int qcol,int vcol,int ocol,int qb,const bf16*Q,const bf16*__restrict__ K,const bf16*__restrict__ V,bf16*O,char*shm,bool comb,const Comb&CB){
  int tid_o=threadIdx.x; asm volatile("":"+v"(tid_o)); const int tid=tid_o,lane=tid&63,r32=lane&31,hi=lane>>5; const int wid=__builtin_amdgcn_readfirstlane(tid>>6);
  const long rowbase=(long)b*SEQ; const int q0=qb*QB;
  const bf16*Qw=Q+(rowbase+q0+wid*QBLK)*DM+qcol;
  const bf16*Kh=K+rowbase*DM+qcol,*Vh=V+rowbase*DM+vcol;
  const unsigned lds0=(unsigned)(uintptr_t)shm;
  float*wsf=(float*)(shm+LDS_WS)+wid*64;
  const bf16*ksrc=Kh+(long)lane*DM+wid*8;
  const bf16*vsrc=Vh+(long)(16*(wid&3)+(lane>>2))*DM+(wid>>2)*32+(lane&3)*8;
  const unsigned kdst=lds0+LDS_K+wid*1024, vdst=lds0+LDS_V+wid*1024;
  #define DMA_K(t,slot) glds16(ksrc+(long)(t)*KVBLK*DM,(unsigned)__builtin_amdgcn_readfirstlane(kdst+(slot)))
  #define DMA_V(t,slot) do{ glds16(vsrc+(long)(t)*KVBLK*DM,(unsigned)__builtin_amdgcn_readfirstlane(vdst+(slot))); glds16(vsrc+64+(long)(t)*KVBLK*DM,(unsigned)__builtin_amdgcn_readfirstlane(vdst+(LDS_V2-LDS_V)+(slot))); }while(0)
  const int vb0=(int)(lds0+LDS_V)+((lane>>4)&1)*32+(lane&3)*8+(4*hi+((lane&15)>>2))*64;
  const char*Kbase=shm+LDS_K; bf16x8 kf[8];
  const lds_cptr shm3=(lds_cptr)shm; const lds_cptr kp0=shm3+LDS_K+hi*1024+r32*16; const lds_cptr vp0=shm3+LDS_V+((lane>>4)&1)*32+(lane&3)*8+(4*hi+((lane&15)>>2))*64;
  const int NT=(q0+QB)/KVBLK;
  DMA_K(0,0);DMA_V(0,0);DMA_K(1,SLOTB);
  bf16x8 qr[4];
  #pragma unroll
  for(int d0=0;d0<4;++d0)qr[d0]=*reinterpret_cast<const bf16x8*>(&Qw[(long)r32*DM+d0*16+hi*8]);
  __attribute__((address_space(3))) char*qst=(__attribute__((address_space(3))) char*)(shm3+LDS_OST+wid*8192+lane*16);
  #pragma unroll
  for(int d0=0;d0<4;++d0)*(__attribute__((address_space(3))) bf16x8*)(qst+d0*1024)=qr[d0];
  #define QRD(k) (*(const __attribute__((address_space(3))) bf16x8*)(qst+(k)*1024))
  float mhat=0.f,l_reg=0.f;f32x16 o[4];o[0]=f32x16{};o[1]=f32x16{};o[2]=f32x16{};o[3]=f32x16{};f32x16 negm=f32x16{};asm volatile("":"+v"(negm));
  const int qrel=wid*QBLK+r32;
  #define CMASK(P0,P1,t) do{int jb_=(t)-(NT-4); if(jb_>=0)cmask(P0,P1,jb_,qrel,hi);}while(0)
  bool resc=false;
  #define START(P0,P1) do{ const float rm=rowmax(P0,P1); resc=false; \
    { const float dl=rm; mhat=fadd_s(mhat,dl); \
      _Pragma("unroll") for(int r=0;r<16;++r){P0[r]=fsub_s(P0[r],dl);P1[r]=fsub_s(P1[r],dl);} \
      _Pragma("unroll") for(int r=0;r<16;++r)negm[r]=-mhat; asm volatile("":"+v"(negm)); } \
    _Pragma("unroll") for(int r=0;r<16;++r)P0[r]=__builtin_amdgcn_exp2f(P0[r]); }while(0)
  #define RESC() do{ if(resc){ asm volatile("s_waitcnt lgkmcnt(0)":::"memory"); \
      _Pragma("unroll") for(int d_=0;d_<4;++d_) _Pragma("unroll") for(int r=0;r<16;++r)o[d_][r]*=wsf[crow(r,hi)]; } }while(0)
  f32x16 pA0,pA1,pB0,pB1;
  int sl_prev=0,sl_cur=0,sl_next=SLOTB;
  #define ROT() do{sl_prev=sl_cur;sl_cur=sl_next;sl_next=(sl_next==(NSLOT-1)*SLOTB)?0:sl_next+SLOTB;}while(0)
  DMA_K(2,2*SLOTB);
  WAIT_BAR(3);
  qkt(pA0,pA1,Kbase,qr,negm,r32,hi);asm volatile("s_nop 15\n\ts_nop 7":"+v"(pA0),"+v"(pA1));CMASK(pA0,pA1,0);
  START(pA0,pA1);
  _Pragma("unroll") for(int r=0;r<16;++r)pA1[r]=__builtin_amdgcn_exp2f(pA1[r]);
  WAIT_BAR(0);
  DMA_K(3,0);DMA_V(1,SLOTB);
  ROT();
  kload8(kf,kp0+sl_cur);
  WAIT_BAR(3);
  s16x4 vlo[8],vhi[8]; u32x4 pw0,pw1,pw2,pw3;
  #define PKW(P,B) cvtpk_s(P[B],P[B+1])
  #define PAF(k) __builtin_bit_cast(bf16x8,pw##k)
  typedef float f32x4_t __attribute__((ext_vector_type(4)));
  #define PAFS(P,b) __builtin_bit_cast(bf16x8,(f32x4_t){P[b],P[(b)+1],P[(b)+2],P[(b)+3]})
  float dummy_pin=0.f;
  #define VFR(i) (bf16x8){vlo[i][0],vlo[i][1],vlo[i][2],vlo[i][3],vhi[i][0],vhi[i][1],vhi[i][2],vhi[i][3]}
  #define PIN(x) asm volatile("":"+v"(x))
  #define MX3(a,b,c) __builtin_fmaxf(__builtin_fmaxf((a),(b)),(c))
  #define GAPA(MF,A0,A1,A2,A3,W0,W1,PW) do{ MF; sacc+=(f32x2_t){A0,A1}; sacc+=(f32x2_t){A2,A3}; PIN(sacc); W0; W1; PIN(PW); SBAR(); }while(0)
  #define EX(v) __builtin_amdgcn_exp2f(v)
  #define GAPB(MF,X,B) do{ MF; X[B]=EX(X[B]); X[B+1]=EX(X[B+1]); X[B+2]=EX(X[B+2]); X[B+3]=EX(X[B+3]); PIN(X); SBAR(); }while(0)
  #define GAPB2(MF,X,B) do{ MF; X[B]=EX(X[B]); X[B+1]=EX(X[B+1]); PIN(X); SBAR(); }while(0)
  #define VRD(i) do{ vlo[i]=vtr(vp_+(((i)>>2)*4096+((i)&3)*1024)); vhi[i]=vtr(vp_+(((i)>>2)*4096+((i)&3)*1024+512)); }while(0)
  #define VRD2(i) do{ vlo[i]=vtr(vp_+((LDS_V2-LDS_V)+((i)>>2)*4096+((i)&3)*1024)); vhi[i]=vtr(vp_+((LDS_V2-LDS_V)+((i)>>2)*4096+((i)&3)*1024+512)); SBAR(); }while(0)
  #define KRD(G,j) do{ if(G){ kload2(kf,kp0+sl_next,j); SBAR(); } }while(0)
  #define STEP(C0,C1,P0,P1,t,GK,GV,GL) do{ SBAR(); \
    const lds_cptr vp_=vp0+sl_prev; \
    VRD(0); SBAR(); f32x2_t sacc={P0[0],P0[1]}; \
    GAPA(C0=__builtin_amdgcn_mfma_f32_32x32x16_bf16(kf[0],qr[0],negm,0,0,0), P0[2],P0[3],P0[4],P0[5],     P0[0]=__uint_as_float(PKW(P0,0)), P0[1]=__uint_as_float(PKW(P0,2)), dummy_pin); \
    VRD(4); SBAR(); GAPA(C1=__builtin_amdgcn_mfma_f32_32x32x16_bf16(kf[1],qr[0],negm,0,0,0), P0[6],P0[7],P0[8],P0[9],     P0[2]=__uint_as_float(PKW(P0,4)), P0[3]=__uint_as_float(PKW(P0,6)), dummy_pin); \
    VRD(1); SBAR(); const bf16x8 qq1_=QRD(1); GAPA(C0=__builtin_amdgcn_mfma_f32_32x32x16_bf16(kf[2],qq1_,C0,0,0,0),   P0[10],P0[11],P0[12],P0[13], P0[4]=__uint_as_float(PKW(P0,8)), P0[5]=__uint_as_float(PKW(P0,10)), dummy_pin); \
    VRD(5); SBAR(); GAPA(C1=__builtin_amdgcn_mfma_f32_32x32x16_bf16(kf[3],qq1_,C1,0,0,0),   P0[14],P0[15],P1[0],P1[1],   P0[6]=__uint_as_float(PKW(P0,12)), P0[7]=__uint_as_float(PKW(P0,14)), dummy_pin); \
    VRD(2); SBAR(); const bf16x8 qq2_=QRD(2); GAPA(C0=__builtin_amdgcn_mfma_f32_32x32x16_bf16(kf[4],qq2_,C0,0,0,0),   P1[2],P1[3],P1[4],P1[5],     P1[0]=__uint_as_float(PKW(P1,0)), P1[1]=__uint_as_float(PKW(P1,2)), dummy_pin); \
    VRD(6); SBAR(); GAPA(C1=__builtin_amdgcn_mfma_f32_32x32x16_bf16(kf[5],qq2_,C1,0,0,0),   P1[6],P1[7],P1[8],P1[9],     P1[2]=__uint_as_float(PKW(P1,4)), P1[3]=__uint_as_float(PKW(P1,6)), dummy_pin); \
    VRD(3); SBAR(); const bf16x8 qq3_=QRD(3); GAPA(C0=__builtin_amdgcn_mfma_f32_32x32x16_bf16(kf[6],qq3_,C0,0,0,0),   P1[10],P1[11],P1[12],P1[13], P1[4]=__uint_as_float(PKW(P1,8)), P1[5]=__uint_as_float(PKW(P1,10)), dummy_pin); \
    VRD(7); SBAR(); GAPA(C1=__builtin_amdgcn_mfma_f32_32x32x16_bf16(kf[7],qq3_,C1,0,0,0),   P1[14],P1[15],0.f,0.f,       P1[6]=__uint_as_float(PKW(P1,12)), P1[7]=__uint_as_float(PKW(P1,14)), dummy_pin); \
    l_reg+=sacc.x+sacc.y; \
    if(GK){DMA_K((t)+3,sl_cur);} if(GV){DMA_V((t)+1,sl_next);} \
    CMASK(C0,C1,t); \
    { float a=MX3(C0[0],C0[1],C1[0]),b=MX3(C0[2],C0[3],C1[1]); a=MX3(a,C1[2],C1[3]); \
      _Pragma("unroll") for(int r=4;r<16;r+=4){a=MX3(a,C0[r],C0[r+1]);b=MX3(b,C0[r+2],C0[r+3]);a=MX3(a,C1[r],C1[r+1]);b=MX3(b,C1[r+2],C1[r+3]);} \
      float rm=__builtin_fmaxf(a,b); { auto rr=__builtin_amdgcn_permlane32_swap(__float_as_uint(rm),__float_as_uint(rm),false,false); rm=__builtin_fmaxf(__uint_as_float(rr[0]),__uint_as_float(rr[1])); } \
      resc=false; \
      if(__builtin_expect(__any(rm>(float)THRL),0)){ const float dl=__builtin_fmaxf(rm,0.f); mhat+=dl; \
        _Pragma("unroll") for(int r=0;r<16;++r){C0[r]-=dl;C1[r]-=dl;} \
        _Pragma("unroll") for(int r=0;r<16;++r)negm[r]=-mhat; asm volatile("":"+v"(negm)); \
        const float f=__builtin_amdgcn_exp2f(-dl); l_reg*=f; if(hi==0)wsf[r32]=f; resc=true; } } \
    SBAR(); \
    GAPB2(o[0]=__builtin_amdgcn_mfma_f32_32x32x16_bf16(PAFS(P0,0),VFR(0),o[0],0,0,0), C0,0); VRD2(0); \
    GAPB2(o[1]=__builtin_amdgcn_mfma_f32_32x32x16_bf16(PAFS(P0,0),VFR(4),o[1],0,0,0), C0,2); VRD2(4); \
    KRD(GL,0); GAPB2(o[0]=__builtin_amdgcn_mfma_f32_32x32x16_bf16(PAFS(P0,4),VFR(1),o[0],0,0,0), C0,4); VRD2(1); \
    KRD(GL,1); GAPB2(o[1]=__builtin_amdgcn_mfma_f32_32x32x16_bf16(PAFS(P0,4),VFR(5),o[1],0,0,0), C0,6); VRD2(5); \
    KRD(GL,2); GAPB2(o[0]=__builtin_amdgcn_mfma_f32_32x32x16_bf16(PAFS(P1,0),VFR(2),o[0],0,0,0), C0,8); VRD2(2); \
    KRD(GL,3); GAPB2(o[1]=__builtin_amdgcn_mfma_f32_32x32x16_bf16(PAFS(P1,0),VFR(6),o[1],0,0,0), C0,10); VRD2(6); \
    GAPB2(o[0]=__builtin_amdgcn_mfma_f32_32x32x16_bf16(PAFS(P1,4),VFR(3),o[0],0,0,0), C0,12); VRD2(3); \
    GAPB2(o[1]=__builtin_amdgcn_mfma_f32_32x32x16_bf16(PAFS(P1,4),VFR(7),o[1],0,0,0), C0,14); VRD2(7); \
    GAPB2(o[2]=__builtin_amdgcn_mfma_f32_32x32x16_bf16(PAFS(P0,0),VFR(0),o[2],0,0,0), C1,0); \
    GAPB2(o[3]=__builtin_amdgcn_mfma_f32_32x32x16_bf16(PAFS(P0,0),VFR(4),o[3],0,0,0), C1,2); \
    GAPB2(o[2]=__builtin_amdgcn_mfma_f32_32x32x16_bf16(PAFS(P0,4),VFR(1),o[2],0,0,0), C1,4); \
    GAPB2(o[3]=__builtin_amdgcn_mfma_f32_32x32x16_bf16(PAFS(P0,4),VFR(5),o[3],0,0,0), C1,6); \
    GAPB2(o[2]=__builtin_amdgcn_mfma_f32_32x32x16_bf16(PAFS(P1,0),VFR(2),o[2],0,0,0), C1,8); \
    GAPB2(o[3]=__builtin_amdgcn_mfma_f32_32x32x16_bf16(PAFS(P1,0),VFR(6),o[3],0,0,0), C1,10); \
    GAPB2(o[2]=__builtin_amdgcn_mfma_f32_32x32x16_bf16(PAFS(P1,4),VFR(3),o[2],0,0,0), C1,12); \
    GAPB2(o[3]=__builtin_amdgcn_mfma_f32_32x32x16_bf16(PAFS(P1,4),VFR(7),o[3],0,0,0), C1,14); \
    }while(0)
  int t=1;
  #undef CMASK
  #define CMASK(P0,P1,t) do{}while(0)
  for(;t+5<NT;t+=2){
    STEP(pB0,pB1,pA0,pA1,t,true,true,true);     WAIT_BAR(3); RESC(); ROT();
    STEP(pA0,pA1,pB0,pB1,t+1,true,true,true);   WAIT_BAR(3); RESC(); ROT();
  }
  #undef CMASK
  #define CMASK(P0,P1,t) do{int jb_=(t)-(NT-4); if(jb_>=0)cmask(P0,P1,jb_,qrel,hi);}while(0)
  #define ENDW(tt) do{ if((tt)+3<NT){WAIT_BAR(3);} else if((tt)+2<NT){WAIT_BAR(2);} else {WAIT_BAR(0);} }while(0)
  for(;t+1<NT;t+=2){
    STEP(pB0,pB1,pA0,pA1,t,(t+3<NT),(t+1<NT),(t+1<NT));       ENDW(t);   RESC(); ROT();
    STEP(pA0,pA1,pB0,pB1,t+1,(t+4<NT),(t+2<NT),(t+2<NT));     ENDW(t+1); RESC(); ROT();
  }
  STEP(pB0,pB1,pA0,pA1,NT-1,false,false,false); RESC();
  { float sacc=pB0[0]+pB0[1]; _Pragma("unroll") for(int r=2;r<16;++r)sacc+=pB0[r]; _Pragma("unroll") for(int r=0;r<16;++r)sacc+=pB1[r]; l_reg+=sacc;
    pw0=(u32x4){PKW(pB0,0),PKW(pB0,2),PKW(pB0,4),PKW(pB0,6)};pw1=(u32x4){PKW(pB0,8),PKW(pB0,10),PKW(pB0,12),PKW(pB0,14)};pw2=(u32x4){PKW(pB1,0),PKW(pB1,2),PKW(pB1,4),PKW(pB1,6)};pw3=(u32x4){PKW(pB1,8),PKW(pB1,10),PKW(pB1,12),PKW(pB1,14)};
    SBAR(); pv(o,vb0+sl_cur,PAF(0),PAF(1),PAF(2),PAF(3)); pv(o+2,vb0+(LDS_V2-LDS_V)+sl_cur,PAF(0),PAF(1),PAF(2),PAF(3)); }
  #undef PKW
  #undef PAF
  #undef PAFS
  #undef VFR
  #undef PIN
  #undef MX3
  #undef GAPA
  #undef GAPB
  #undef GAPB2
  #undef EX
  #undef VRD
  #undef VRD2
  #undef QRD
  #undef KRD
  #undef STEP
  #undef ENDW
  {auto rr=__builtin_amdgcn_permlane32_swap(__float_as_uint(l_reg),__float_as_uint(l_reg),false,false);l_reg=__uint_as_float(rr[0])+__uint_as_float(rr[1]);}
  if(hi==0)wsf[32+r32]=l_reg;asm volatile("s_waitcnt lgkmcnt(0)":::"memory");
  float rli[16];
  #pragma unroll
  for(int r=0;r<16;++r)rli[r]=__builtin_amdgcn_rcpf(wsf[32+crow(r,hi)]);
  bf16*Ow=O+(rowbase+q0+wid*QBLK)*OPITCH+ocol;
  { bf16*stg=(bf16*)(shm+LDS_OST)+wid*4096;
    #pragma unroll
    for(int r=0;r<16;++r){const int orow=crow(r,hi);
      #pragma unroll
      for(int d0=0;d0<4;++d0)stg[orow*128+d0*32+r32]=__float2bfloat16(o[d0][r]*rli[r]);}
    asm volatile("s_waitcnt lgkmcnt(0)":::"memory");
    if(!comb){
      #pragma unroll
      for(int i=0;i<8;++i){const int row=i*4+(lane>>4),ch=lane&15; const u32x4 v=*(const u32x4*)(stg+row*128+ch*8); ATTN_STORE16(Ow+(long)row*OPITCH+ch*8,v);}
    } else {
      const int hcol=(ocol>>8)*128; const float post=1.f-CB.lam_init;
      #pragma unroll
      for(int i=0;i<8;++i){const int row=i*4+(lane>>4),ch=lane&15;
        const u32x4 v1=*(const u32x4*)(stg+row*128+ch*8); const u32x4 v0=*(const u32x4*)(Ow-128+(long)row*OPITCH+ch*8);
        float d[8]; float ss=0.f;
        #pragma unroll
        for(int w=0;w<4;++w){ d[2*w]=__uint_as_float(v0[w]<<16)-CB.lamf*__uint_as_float(v1[w]<<16); d[2*w+1]=__uint_as_float(v0[w]&0xffff0000u)-CB.lamf*__uint_as_float(v1[w]&0xffff0000u); ss+=d[2*w]*d[2*w]+d[2*w+1]*d[2*w+1]; }
        _Pragma("unroll") for(int sx=1;sx<16;sx<<=1) ss+=__int_as_float(__builtin_amdgcn_ds_bpermute((lane^sx)<<2,__float_as_int(ss)));
        const float rn=rsqrtf(ss*(1.f/128.f)+1e-6f)*post;
        const float*gp=CB.gh+hcol+ch*8; const float4 g0=*(const float4*)gp,g1=*(const float4*)(gp+4);
        u32x4 ov; ov[0]=cvtpk_s(d[0]*rn*g0.x,d[1]*rn*g0.y); ov[1]=cvtpk_s(d[2]*rn*g0.z,d[3]*rn*g0.w); ov[2]=cvtpk_s(d[4]*rn*g1.x,d[5]*rn*g1.y); ov[3]=cvtpk_s(d[6]*rn*g1.z,d[7]*rn*g1.w);
        *(u32x4*)(CB.XA+(rowbase+q0+wid*QBLK+row)*DM+hcol+ch*8)=ov; }
    } }
  asm volatile("s_waitcnt lgkmcnt(0)\n\ts_barrier":::"memory");
  #undef DMA_K
  #undef DMA_V
  #undef CMASK
  #undef START
  #undef RESC
  #undef ROT
}
constexpr int ATTN_LDS_BYTES=LDS_BYTES;
struct AttnTensors { const bf16* Q; const bf16* K; const bf16* V; bf16* O; };
template<int THRL=8> __device__ __forceinline__ void attn_phase(char*lds,const AttnTensors&T,const Comb&CB,int grid,int block){
  const bool fast=(grid==256);
  for(int i=0;;++i){
    int bh,j;
    if(fast){ if(i>=8)break; bh=(i>>2)*8+(block&7); j=block>>3; }
    else { const long p=(long)(i>>2)*grid+block; if(p>=16*32)break; bh=(int)(p>>5); j=(int)(p&31); }
    const int c=i&1, qb=(i&2)?(NQB-1-j):j, b=bh>>3, vh=(bh&7)*2+c;
    attn_unit<THRL>(b,vh*64,(vh>>1)*128,vh*128,qb,T.Q,T.K,T.V,T.O,lds,c==1,CB);
  }
}
#undef SBAR
#undef WAIT_BAR
}

namespace cg = cooperative_groups;
#define LAS __attribute__((address_space(3)))
typedef unsigned short bf16;
typedef unsigned v4u __attribute__((ext_vector_type(4)));
typedef unsigned v2u __attribute__((ext_vector_type(2)));
typedef float f32x4 __attribute__((ext_vector_type(4)));
typedef short bf16x8 __attribute__((ext_vector_type(8)));
#ifndef PROBE_ATTN
#define PROBE_ATTN 1
#endif
#ifndef PROBE_GEMM
#define PROBE_GEMM 1
#endif
#ifndef PROBE_M
#define PROBE_M 1
#endif
#ifndef MK_MULTI
#define MK_MULTI 0
#endif
constexpr int NWAVES = 8, NTHR = 512;
constexpr int BATCH = 2, SEQ = 16384, DM = 1024, TT = BATCH * SEQ, FF = 4096;
constexpr int MPROJ = 3080, NPROJ = 3072;
constexpr float EPS = 1e-6f;
constexpr float KSCALE = 0.08838834764831845f;
constexpr int NPH = 33;
constexpr size_t MiB = 1u << 20;
constexpr size_t WS_WA = 2 * MiB, WS_WO = 8 * MiB, WS_WU = 10 * MiB, WS_WD = 18 * MiB;
constexpr size_t WS_XN = 32 * MiB;
constexpr size_t WS_K = 96 * MiB, WS_V = 160 * MiB;
constexpr size_t WS_PROJ = 96 * MiB;
constexpr size_t WS_ST = 288 * MiB;
constexpr size_t WS_YA = 416 * MiB;
constexpr size_t WS_Q = 224 * MiB;
constexpr size_t WS_O = 288 * MiB;
constexpr size_t WS_H = 224 * MiB;
constexpr size_t WS_ROPE = 480 * MiB;
constexpr size_t WS_G = 488 * MiB;
constexpr size_t WS_DEC = 489 * MiB;
constexpr size_t WS_NST = 490 * MiB;
constexpr size_t WS_END = 491 * MiB;
constexpr int CW_BAR = 4096;
constexpr size_t CTL_ZERO_BYTES = 65536;
constexpr int LDS_BYTES = 147456;

struct Args {
    const float* x; const int* pos; const float* norm_g; const float* a_w_in; const float* a_b_gates; const float* a_g_head; const float* a_w_out;
    const float* kv_norm_g; const float* w_kv; const float* b_w_q; const float* b_lam; const float* b_g_head; const float* b_w_out;
    const float* mlp_up; const float* mlp_down; float* out; unsigned char* ws;
    float lam_init[2]; int ph_lo_, ph_hi_;
};

__device__ __forceinline__ unsigned f2bf(float f) { unsigned u = __builtin_bit_cast(unsigned, f); return (u + 0x7fffu + ((u >> 16) & 1u)) >> 16; }
typedef float f32x2g_t __attribute__((ext_vector_type(2))); typedef __bf16 bf16x2g_t __attribute__((ext_vector_type(2)));
__device__ __forceinline__ unsigned pk2(float lo, float hi) { const f32x2g_t v = {lo, hi}; const bf16x2g_t b = __builtin_convertvector(v, bf16x2g_t); return __builtin_bit_cast(unsigned, b); }
__device__ __forceinline__ float bflo(unsigned w) { return __uint_as_float(w << 16); }
__device__ __forceinline__ float bfhi(unsigned w) { return __uint_as_float(w & 0xffff0000u); }
__device__ __forceinline__ float shx(float v, int o, int lane) { return __int_as_float(__builtin_amdgcn_ds_bpermute((lane ^ o) << 2, __float_as_int(v))); }
__device__ __forceinline__ float shl_(float v, int src) { return __int_as_float(__builtin_amdgcn_ds_bpermute(src << 2, __float_as_int(v))); }
__device__ __forceinline__ float wave_sum(float v, int lane) {
#pragma unroll
    for (int o = 1; o < 64; o <<= 1) v += shx(v, o, lane);
    return v;
}
__device__ __forceinline__ float fexp(float x) { return __builtin_amdgcn_exp2f(x * 1.4426950408889634f); }
#define MFMA16(a, b, c) __builtin_amdgcn_mfma_f32_16x16x32_bf16((a), (b), (c), 0, 0, 0)

__device__ __forceinline__ int rope_perm(int c) { const int w = c & 63; return (c & ~63) + 8 * ((w & 31) >> 2) + 4 * (w >> 5) + (w & 3); }
__device__ __forceinline__ void transpose_item(const float* W, int K, int ldw, int N, bf16* WT, LAS float* scr, int item, int lane, int perm_lim) {
    const int nblk = N / 32, kb = item / nblk, nb = item % nblk, k0 = 64 * kb, n0 = 32 * nb;
    float wv[32];
#pragma unroll
    for (int i = 0; i < 32; ++i) wv[i] = W[(size_t)(k0 + 2 * i + (lane >> 5)) * ldw + n0 + (lane & 31)];
#pragma unroll
    for (int i = 0; i < 32; ++i) scr[(2 * i + (lane >> 5)) * 33 + (lane & 31)] = wv[i];
    asm volatile("s_waitcnt lgkmcnt(0)" ::: "memory");
    const int c = lane & 7;
#pragma unroll
    for (int j = 0; j < 4; ++j) { const int n = (lane >> 3) + 8 * j; const LAS float* s = scr + (8 * c) * 33 + n;
        v4u o; o.x = pk2(s[0 * 33], s[1 * 33]); o.y = pk2(s[2 * 33], s[3 * 33]); o.z = pk2(s[4 * 33], s[5 * 33]); o.w = pk2(s[6 * 33], s[7 * 33]);
        const int nn = n0 + n, nd = (nn < perm_lim) ? rope_perm(nn) : nn;
        *(v4u*)(WT + (size_t)nd * K + k0 + 8 * c) = o; }
    asm volatile("s_waitcnt lgkmcnt(0)" ::: "memory");
}
__device__ __forceinline__ void conv_weights(const Args& a, int L, LAS unsigned char* lds, int gw, int NGW, int wave, int lane) {
    LAS float* scr = (LAS float*)(lds + wave * 16384);
    unsigned char* ws = a.ws;
    const float* W0; int K0, ld0, N0; const float* W1 = nullptr; int N1 = 0, ld1 = 0;
    const float* Wo;
    if (L < 2) { W0 = a.a_w_in + (size_t)L * DM * MPROJ; K0 = DM; ld0 = MPROJ; N0 = NPROJ; Wo = a.a_w_out + (size_t)L * DM * DM; }
    else { W0 = a.b_w_q + (size_t)(L - 2) * DM * DM; K0 = DM; ld0 = DM; N0 = DM; Wo = a.b_w_out + (size_t)(L - 2) * DM * DM; if (L == 2) { W1 = a.w_kv; N1 = 2 * DM; ld1 = 2 * DM; } }
    const float* Wu = a.mlp_up + (size_t)L * DM * FF; const float* Wd = a.mlp_down + (size_t)L * FF * DM;
    const int I0 = (K0 / 64) * (N0 / 32), I1 = (DM / 64) * (N1 / 32), IO = (DM / 64) * (DM / 32), IU = (DM / 64) * (FF / 32), ID = (FF / 64) * (DM / 32);
    const int NIT = I0 + I1 + IO + IU + ID;
    for (int it = gw; it < NIT; it += NGW) {
        int r = it;
        if (r < I0) { transpose_item(W0, K0, ld0, N0, (bf16*)(ws + WS_WA), scr, r, lane, (L >= 2) ? DM : 0); continue; } r -= I0;
        if (r < I1) { transpose_item(W1, DM, ld1, N1, (bf16*)(ws + WS_WA) + (size_t)DM * DM, scr, r, lane, DM); continue; } r -= I1;
        if (r < IO) { transpose_item(Wo, DM, DM, DM, (bf16*)(ws + WS_WO), scr, r, lane, 0); continue; } r -= IO;
        if (r < IU) { transpose_item(Wu, DM, FF, FF, (bf16*)(ws + WS_WU), scr, r, lane, 0); continue; } r -= IU;
        transpose_item(Wd, FF, DM, DM, (bf16*)(ws + WS_WD), scr, r, lane, 0);
    }
}

__device__ __forceinline__ void rope_table(const int* pos, float* tab, int gtid, int nthr) {
    for (int idx = gtid; idx < TT * 32; idx += nthr) {
        const int t = idx >> 5, i = idx & 31;
        double p = 1.0;
        for (int k = 0; k < i; ++k) p *= 1.333521432163324;
        const float inv = 1.0f / (float)p;
        const float ang = (float)pos[t] * inv;
        const double rev = (double)ang * 0.15915494309189535;
        const double fr = rev - rint(rev);
        const double q = rint(fr * 4.0);
        const float r = (float)((fr - q * 0.25) * 6.283185307179586);
        const float r2 = r * r;
        const float sn = r * (1.f + r2 * (-1.f / 6.f + r2 * (1.f / 120.f + r2 * (-1.f / 5040.f + r2 * (1.f / 362880.f)))));
        const float cs = 1.f + r2 * (-0.5f + r2 * (1.f / 24.f + r2 * (-1.f / 720.f + r2 * (1.f / 40320.f))));
        const int qi = ((int)q) & 3;
        const float c = (qi == 0) ? cs : (qi == 1) ? -sn : (qi == 2) ? -cs : sn;
        const float s = (qi == 0) ? sn : (qi == 1) ? cs : (qi == 2) ? -sn : -cs;
        tab[(size_t)t * 64 + i] = c; tab[(size_t)t * 64 + 32 + i] = s;
    }
}

struct NormJob { const float* xin; float* xout; const bf16* Y; const float* gpost; const float* gpre; bf16* XN; const float* gkv; bf16* XKV; const float* wg; const float* bg; float* G; };
__device__ __forceinline__ float softcap15(float z) { const float e = fexp(fminf(z * (2.f / 15.f), 80.f)); return 15.f * ((e - 1.f) / (e + 1.f)); }
__device__ __forceinline__ void norm_phase(const NormJob& J, LAS unsigned char* lds, int gw, int NGW, int tid, int lane) {
    LAS float* wl = (LAS float*)lds;
    if (J.wg) {
        for (int i = tid; i < 8192; i += NTHR) { const int d = i >> 3, q = i & 7; wl[q * 1024 + d] = J.wg[(size_t)d * MPROJ + q]; }
        __syncthreads();
    }
    constexpr int NR = 2;
    f32x4 nxv[2][NR][4]; v2u nyw[2][NR][4];
#pragma unroll
    for (int d = 0; d < 2; ++d)
#pragma unroll
        for (int r = 0; r < NR; ++r)
#pragma unroll
            for (int j = 0; j < 4; ++j) { nxv[d][r][j] = (f32x4){0.f, 0.f, 0.f, 0.f}; nyw[d][r][j] = (v2u){0u, 0u}; }
#pragma unroll
    for (int d = 0; d < 2; ++d) { const int mf = gw * NR + d * NGW * NR;
        if (mf < TT) {
#pragma unroll
            for (int r = 0; r < NR; ++r)
#pragma unroll
                for (int j = 0; j < 4; ++j) nxv[d][r][j] = __builtin_nontemporal_load((const f32x4*)(J.xin + (size_t)(mf + r) * DM) + lane + 64 * j);
            if (J.Y) {
#pragma unroll
                for (int r = 0; r < NR; ++r)
#pragma unroll
                    for (int j = 0; j < 4; ++j) nyw[d][r][j] = __builtin_nontemporal_load((const v2u*)(J.Y + (size_t)(mf + r) * DM) + lane + 64 * j); }
        } }
    for (int m0 = gw * NR; m0 < TT; m0 += NGW * NR) {
        f32x4 v[NR][4]; v2u yw[NR][4];
#pragma unroll
        for (int r = 0; r < NR; ++r)
#pragma unroll
            for (int j = 0; j < 4; ++j) { v[r][j] = nxv[0][r][j]; yw[r][j] = nyw[0][r][j]; nxv[0][r][j] = nxv[1][r][j]; nyw[0][r][j] = nyw[1][r][j]; }
        { const int m2 = m0 + 2 * NGW * NR;
          if (m2 < TT) {
#pragma unroll
            for (int r = 0; r < NR; ++r)
#pragma unroll
                for (int j = 0; j < 4; ++j) nxv[1][r][j] = __builtin_nontemporal_load((const f32x4*)(J.xin + (size_t)(m2 + r) * DM) + lane + 64 * j);
            if (J.Y) {
#pragma unroll
                for (int r = 0; r < NR; ++r)
#pragma unroll
                    for (int j = 0; j < 4; ++j) nyw[1][r][j] = __builtin_nontemporal_load((const v2u*)(J.Y + (size_t)(m2 + r) * DM) + lane + 64 * j); }
          } }
        if (J.Y) {
            float s[NR];
            f32x4 y[NR][4];
#pragma unroll
            for (int r = 0; r < NR; ++r) { s[r] = 0.f;
#pragma unroll
                for (int j = 0; j < 4; ++j) { const v2u w = yw[r][j]; y[r][j] = (f32x4){bflo(w.x), bfhi(w.x), bflo(w.y), bfhi(w.y)}; s[r] += (y[r][j].x * y[r][j].x + y[r][j].y * y[r][j].y) + (y[r][j].z * y[r][j].z + y[r][j].w * y[r][j].w); } }
#pragma unroll
            for (int o = 1; o < 64; o <<= 1) {
#pragma unroll
                for (int r = 0; r < NR; ++r) s[r] += shx(s[r], o, lane); }
#pragma unroll
            for (int r = 0; r < NR; ++r) { const float rr = rsqrtf(s[r] * (1.f / DM) + EPS);
                f32x4* xo = (f32x4*)(J.xout + (size_t)(m0 + r) * DM) + lane;
#pragma unroll
                for (int j = 0; j < 4; ++j) { const f32x4 gp = ((const f32x4*)J.gpost)[lane + 64 * j]; v[r][j] = v[r][j] + y[r][j] * rr * gp; __builtin_nontemporal_store(v[r][j], xo + 64 * j); } }
        }
        if (J.gpre) {
            float s2[NR];
#pragma unroll
            for (int r = 0; r < NR; ++r) { s2[r] = 0.f;
#pragma unroll
                for (int j = 0; j < 4; ++j) s2[r] += (v[r][j].x * v[r][j].x + v[r][j].y * v[r][j].y) + (v[r][j].z * v[r][j].z + v[r][j].w * v[r][j].w); }
#pragma unroll
            for (int o = 1; o < 64; o <<= 1) {
#pragma unroll
                for (int r = 0; r < NR; ++r) s2[r] += shx(s2[r], o, lane); }
#pragma unroll
            for (int r = 0; r < NR; ++r) { const int m = m0 + r;
                const float r2 = rsqrtf(s2[r] * (1.f / DM) + EPS);
                v2u* xn = (v2u*)(J.XN + (size_t)m * DM) + lane;
                f32x4 hn[4];
#pragma unroll
                for (int j = 0; j < 4; ++j) { const f32x4 g = ((const f32x4*)J.gpre)[lane + 64 * j]; hn[j] = v[r][j] * r2 * g; v2u w; w.x = pk2(hn[j].x, hn[j].y); w.y = pk2(hn[j].z, hn[j].w); xn[64 * j] = w; }
                if (J.gkv) {
                    v2u* xk = (v2u*)(J.XKV + (size_t)m * DM) + lane;
#pragma unroll
                    for (int j = 0; j < 4; ++j) { const f32x4 g = ((const f32x4*)J.gkv)[lane + 64 * j]; const f32x4 hk = v[r][j] * r2 * g; v2u w; w.x = pk2(hk.x, hk.y); w.y = pk2(hk.z, hk.w); xk[64 * j] = w; }
                }
                if (J.wg) {
                    float ga[8];
#pragma unroll
                    for (int q = 0; q < 8; ++q) { float sq = 0.f;
#pragma unroll
                        for (int j = 0; j < 4; ++j) { const f32x4 w = *(const LAS f32x4*)(wl + q * 1024 + 4 * lane + 256 * j); sq += (hn[j].x * w.x + hn[j].y * w.y) + (hn[j].z * w.z + hn[j].w * w.w); }
                        ga[q] = sq; }
#pragma unroll
                    for (int o = 1; o < 64; o <<= 1) {
#pragma unroll
                        for (int q = 0; q < 8; ++q) ga[q] += shx(ga[q], o, lane); }
                    const int q = lane & 7;
                    float z = (q == 0) ? ga[0] : (q == 1) ? ga[1] : (q == 2) ? ga[2] : (q == 3) ? ga[3] : (q == 4) ? ga[4] : (q == 5) ? ga[5] : (q == 6) ? ga[6] : ga[7];
                    z = softcap15(z + J.bg[q]);
                    if (q >= 4) z = fminf(z, 0.f) - __logf(1.f + fexp(-fabsf(z)));
                    if (lane < 8) J.G[(size_t)m * 8 + q] = z;
                }
            }
        }
    }
}

constexpr int VTP = 144;
constexpr int QP = 272;
constexpr int APP = 400;
constexpr int HSP = 260;

__device__ __forceinline__ unsigned elem16(const v4u& v, int i) { return (v[i >> 1] >> (16 * (i & 1))) & 0xffffu; }

__device__ __forceinline__ void m1_phase(LAS unsigned char* lds, const bf16* proj, const float* Gt, bf16* ST, float* dec, float* nst, int nblk, int bx, int tid, int lane, int wave) {
    LAS unsigned char* vT = lds; LAS unsigned char* kT = lds + 36864; LAS float* wsv = (LAS float*)(lds + 55296);
    const int fr = lane & 15, fg = lane >> 4, lp = tid & 31, pcg = tid >> 5;
    for (int unit = bx; unit < 2048; unit += nblk) {
        const int b = unit >> 10, h = (unit >> 8) & 3, c = unit & 255; const size_t t0 = (size_t)b * SEQ + (size_t)c * 64;
        if (wave == 0) {
            const float lf = Gt[(t0 + lane) * 8 + 4 + h], li = Gt[(t0 + lane) * 8 + h];
            float bs = lf;
#pragma unroll
            for (int o = 1; o < 64; o <<= 1) { const float t = shl_(bs, lane - o); if (lane >= o) bs += t; }
            const float bl = shl_(bs, 63);
            wsv[lane] = fexp(bl - bs + li) * KSCALE;
            if (lane == 63) dec[unit] = fexp(bl);
        }
        const bf16* r0 = proj + (t0 + 2 * lp) * NPROJ; const bf16* r1 = r0 + NPROJ;
        v4u va[2], vb[2];
#pragma unroll
        for (int n = 0; n < 2; ++n) { va[n] = *(const v4u*)(r0 + 1024 + h * 256 + 8 * (pcg + 16 * n)); vb[n] = *(const v4u*)(r1 + 1024 + h * 256 + 8 * (pcg + 16 * n)); }
        const v4u ka = *(const v4u*)(r0 + 512 + h * 128 + 8 * pcg), kb = *(const v4u*)(r1 + 512 + h * 128 + 8 * pcg);
        __syncthreads();
#pragma unroll
        for (int n = 0; n < 2; ++n)
#pragma unroll
            for (int i = 0; i < 8; ++i) *(LAS unsigned*)(vT + (8 * (pcg + 16 * n) + i) * VTP + lp * 4) = elem16(va[n], i) | (elem16(vb[n], i) << 16);
        const float w0 = wsv[2 * lp], w1 = wsv[2 * lp + 1];
#pragma unroll
        for (int i = 0; i < 8; ++i) *(LAS unsigned*)(kT + (8 * pcg + i) * VTP + lp * 4) = pk2(__uint_as_float(elem16(ka, i) << 16) * w0, __uint_as_float(elem16(kb, i) << 16) * w1);
        __syncthreads();
        f32x4 acc[2][8];
#pragma unroll
        for (int mt = 0; mt < 2; ++mt)
#pragma unroll
            for (int nt = 0; nt < 8; ++nt) acc[mt][nt] = (f32x4){0.f, 0.f, 0.f, 0.f};
#pragma unroll
        for (int ks = 0; ks < 2; ++ks) {
            bf16x8 vf[2];
#pragma unroll
            for (int mt = 0; mt < 2; ++mt) vf[mt] = *(const LAS bf16x8*)(vT + (32 * wave + 16 * mt + fr) * VTP + (32 * ks + 8 * fg) * 2);
#pragma unroll
            for (int nt = 0; nt < 8; ++nt) { const bf16x8 kf = *(const LAS bf16x8*)(kT + (16 * nt + fr) * VTP + (32 * ks + 8 * fg) * 2);
#pragma unroll
                for (int mt = 0; mt < 2; ++mt) acc[mt][nt] = MFMA16(kf, vf[mt], acc[mt][nt]); }
        }
        bf16* sp = ST + (size_t)unit * 32768;
        {
            LAS unsigned char* stg = lds + 57344 + wave * 8704;
#pragma unroll
            for (int mt = 0; mt < 2; ++mt)
#pragma unroll
                for (int nt = 0; nt < 8; ++nt) { v2u w; w.x = pk2(acc[mt][nt][0], acc[mt][nt][1]); w.y = pk2(acc[mt][nt][2], acc[mt][nt][3]);
                    *(LAS v2u*)(stg + (16 * mt + fr) * 272 + (16 * nt + 4 * fg) * 2) = w; }
#pragma unroll
            for (int i = 0; i < 8; ++i) { const int et = i >> 2, k2 = i & 3;
                const v4u v = *(const LAS v4u*)(stg + (16 * et + fr) * 272 + (32 * k2 + 8 * fg) * 2);
                *(v4u*)(sp + (size_t)((((wave * 2 + et) * 4 + k2) * 64 + lane) * 8)) = v; }
        }
        if (tid < 128) { float s = 0.f;
#pragma unroll
            for (int i = 0; i < 8; ++i) { const v4u w = *(const LAS v4u*)(kT + tid * VTP + i * 16);
#pragma unroll
                for (int e = 0; e < 4; ++e) s += bflo(w[e]) + bfhi(w[e]); }
            nst[(size_t)unit * 128 + tid] = s; }
        __syncthreads();
    }
}

__device__ __forceinline__ void m2_phase(bf16* ST, const float* dec, float* nst, int gtid, int nthr) {
    for (int chain = gtid; chain < 8 * 16384; chain += nthr) {
        const int bh = chain >> 14, idx = chain & 16383;
        unsigned* p = (unsigned*)ST + (size_t)bh * 256 * 16384 + idx; const float* dc = dec + bh * 256;
        float r0 = 0.f, r1 = 0.f;
        for (int c0 = 0; c0 < 256; c0 += 32) {
            unsigned v[32];
#pragma unroll
            for (int i = 0; i < 32; ++i) v[i] = p[(size_t)(c0 + i) * 16384];
#pragma unroll
            for (int i = 0; i < 32; ++i) { const float d = dc[c0 + i]; p[(size_t)(c0 + i) * 16384] = pk2(r0, r1); r0 = d * r0 + bflo(v[i]); r1 = d * r1 + bfhi(v[i]); }
        }
    }
    for (int chain = gtid; chain < 8 * 128; chain += nthr) {
        const int bh = chain >> 7, d = chain & 127;
        float* p = nst + (size_t)bh * 256 * 128 + d; const float* dc = dec + bh * 256;
        float r = 0.f;
        for (int c0 = 0; c0 < 256; c0 += 16) {
            float v[16];
#pragma unroll
            for (int i = 0; i < 16; ++i) v[i] = p[(c0 + i) * 128];
#pragma unroll
            for (int i = 0; i < 16; ++i) { const float dd = dc[c0 + i]; p[(c0 + i) * 128] = r; r = dd * r + v[i]; }
        }
    }
}

__device__ __forceinline__ void m3_phase(LAS unsigned char* lds, const bf16* proj, const float* Gt, const bf16* ST, const float* nst, const float* gh, bf16* YA, int nblk, int bx, int tid, int lane, int wave) {
    LAS unsigned char* qs = lds; LAS unsigned char* ksm = lds + 17408; LAS unsigned char* vT = lds + 34816; LAS unsigned char* Ap = lds + 71680;
    LAS float* bcs = (LAS float*)(lds + 97280); LAS float* lis = (LAS float*)(lds + 97536); LAS float* rsum = (LAS float*)(lds + 97792); LAS float* denq = (LAS float*)(lds + 98816);
    LAS float* Hs = (LAS float*)lds;
    const int fr = lane & 15, fg = lane >> 4, lp = tid & 31, pcg = tid >> 5;
    const int j2 = tid >> 3, part = tid & 7;
#define M3_LOAD(U, QV, KV, VA, VB, GLF, GLI) do { const int ub_ = (U) >> 10, uh_ = ((U) >> 8) & 3, uc_ = (U) & 255; const size_t ut0_ = (size_t)ub_ * SEQ + (size_t)uc_ * 64; \
        _Pragma("unroll") for (int n = 0; n < 2; ++n) { const int p = tid + 512 * n, row = p >> 4, pc = p & 15; const bf16* rp = proj + (ut0_ + row) * NPROJ + uh_ * 128 + 8 * pc; QV[n] = *(const v4u*)rp; KV[n] = *(const v4u*)(rp + 512); } \
        { const bf16* r0_ = proj + (ut0_ + 2 * lp) * NPROJ; const bf16* r1_ = r0_ + NPROJ; \
          _Pragma("unroll") for (int n = 0; n < 2; ++n) { VA[n] = *(const v4u*)(r0_ + 1024 + uh_ * 256 + 8 * (pcg + 16 * n)); VB[n] = *(const v4u*)(r1_ + 1024 + uh_ * 256 + 8 * (pcg + 16 * n)); } } \
        GLF = Gt[(ut0_ + lane) * 8 + 4 + uh_]; GLI = Gt[(ut0_ + lane) * 8 + uh_]; } while (0)
    v4u nqv[2], nkv[2], nva[2], nvb[2]; float nlf = 0.f, nli = 0.f;
#pragma unroll
    for (int n = 0; n < 2; ++n) { nqv[n] = (v4u){0u, 0u, 0u, 0u}; nkv[n] = nqv[n]; nva[n] = nqv[n]; nvb[n] = nqv[n]; }
    if (bx < 2048) M3_LOAD(bx, nqv, nkv, nva, nvb, nlf, nli);
    for (int unit = bx; unit < 2048; unit += nblk) {
        const int b = unit >> 10, h = (unit >> 8) & 3, c = unit & 255; const size_t t0 = (size_t)b * SEQ + (size_t)c * 64;
        v4u qv[2], kv[2], va[2], vb[2], cf[2][4], ovp[4]; f32x4 nv[4];
#pragma unroll
        for (int n = 0; n < 2; ++n) { qv[n] = nqv[n]; kv[n] = nkv[n]; va[n] = nva[n]; vb[n] = nvb[n]; }
        { const bf16* sp = ST + (size_t)unit * 32768;
#pragma unroll
            for (int et = 0; et < 2; ++et)
#pragma unroll
                for (int k2 = 0; k2 < 4; ++k2) cf[et][k2] = *(const v4u*)(sp + (size_t)((((wave * 2 + et) * 4 + k2) * 64 + lane) * 8)); }
#pragma unroll
        for (int i = 0; i < 4; ++i) { ovp[i] = *(const v4u*)(proj + (t0 + j2) * NPROJ + 2048 + h * 256 + 64 * i + 8 * part); nv[i] = *(const f32x4*)(nst + (size_t)unit * 128 + 16 * part + 4 * i); }
        if (wave == 0) {
            const float lf = nlf, li = nli;
            float bs = lf;
#pragma unroll
            for (int o = 1; o < 64; o <<= 1) { const float t = shl_(bs, lane - o); if (lane >= o) bs += t; }
            bcs[lane] = bs; lis[lane] = li;
        }
        __syncthreads();
#pragma unroll
        for (int n = 0; n < 2; ++n) { const int p = tid + 512 * n, row = p >> 4, pc = p & 15;
            *(LAS v4u*)(qs + row * QP + pc * 16) = qv[n]; *(LAS v4u*)(ksm + row * QP + pc * 16) = kv[n];
            const float eb = fexp(bcs[row]); v4u e;
#pragma unroll
            for (int w = 0; w < 4; ++w) e[w] = pk2(bflo(qv[n][w]) * eb, bfhi(qv[n][w]) * eb);
            *(LAS v4u*)(Ap + row * APP + 128 + pc * 16) = e; }
#pragma unroll
        for (int n = 0; n < 2; ++n)
#pragma unroll
            for (int i = 0; i < 8; ++i) *(LAS unsigned*)(vT + (8 * (pcg + 16 * n) + i) * VTP + lp * 4) = elem16(va[n], i) | (elem16(vb[n], i) << 16);
        { const int nu = unit + nblk; if (nu < 2048) M3_LOAD(nu, nqv, nkv, nva, nvb, nlf, nli); }
        __syncthreads();
        {
            const int jt = wave >> 1, j = 16 * jt + fr; const float bj = bcs[j];
#pragma unroll
            for (int sti = 0; sti < 2; ++sti) { const int st = 2 * (wave & 1) + sti;
                f32x4 acc = (f32x4){0.f, 0.f, 0.f, 0.f};
#pragma unroll
                for (int ks = 0; ks < 4; ++ks) { const bf16x8 kf = *(const LAS bf16x8*)(ksm + (16 * st + fr) * QP + (32 * ks + 8 * fg) * 2); const bf16x8 qf = *(const LAS bf16x8*)(qs + j * QP + (32 * ks + 8 * fg) * 2); acc = MFMA16(kf, qf, acc); }
                float val[4]; float rs = 0.f;
#pragma unroll
                for (int jj = 0; jj < 4; ++jj) { const int s = 16 * st + 4 * fg + jj; const float wgt = (s <= j) ? fexp(bj - bcs[s] + lis[s]) : 0.f; val[jj] = (s <= j) ? acc[jj] * KSCALE * wgt : 0.f; rs += val[jj]; }
                rs += shx(rs, 16, lane); rs += shx(rs, 32, lane);
                if (fg == 0) rsum[j * 4 + st] = rs;
                v2u w; w.x = pk2(val[0], val[1]); w.y = pk2(val[2], val[3]);
                *(LAS v2u*)(Ap + j * APP + (16 * st + 4 * fg) * 2) = w; }
        }
        {
            const v4u q0 = *(const LAS v4u*)(qs + j2 * QP + part * 32), q1 = *(const LAS v4u*)(qs + j2 * QP + part * 32 + 16);
            float s = 0.f;
#pragma unroll
            for (int w = 0; w < 4; ++w) { s += bflo(q0[w]) * nv[w >> 1][(2 * w) & 3] + bfhi(q0[w]) * nv[w >> 1][(2 * w + 1) & 3]; s += bflo(q1[w]) * nv[2 + (w >> 1)][(2 * w) & 3] + bfhi(q1[w]) * nv[2 + (w >> 1)][(2 * w + 1) & 3]; }
            s += shx(s, 1, lane); s += shx(s, 2, lane); s += shx(s, 4, lane);
            if (part == 0) denq[j2] = fexp(bcs[j2]) * s;
        }
        __syncthreads();
        f32x4 acc2[2][4];
#pragma unroll
        for (int et = 0; et < 2; ++et)
#pragma unroll
            for (int jt = 0; jt < 4; ++jt) acc2[et][jt] = (f32x4){0.f, 0.f, 0.f, 0.f};
#pragma unroll
        for (int ks = 0; ks < 6; ++ks) {
            bf16x8 af[2];
#pragma unroll
            for (int et = 0; et < 2; ++et) af[et] = (ks < 2) ? *(const LAS bf16x8*)(vT + (32 * wave + 16 * et + fr) * VTP + (32 * ks + 8 * fg) * 2) : __builtin_bit_cast(bf16x8, cf[et][(ks < 2) ? 0 : ks - 2]);
#pragma unroll
            for (int jt = 0; jt < 4; ++jt) { const bf16x8 bq = *(const LAS bf16x8*)(Ap + (16 * jt + fr) * APP + (32 * ks + 8 * fg) * 2);
#pragma unroll
                for (int et = 0; et < 2; ++et) acc2[et][jt] = MFMA16(af[et], bq, acc2[et][jt]); }
        }
        __syncthreads();
#pragma unroll
        for (int et = 0; et < 2; ++et)
#pragma unroll
            for (int jt = 0; jt < 4; ++jt) *(LAS f32x4*)(Hs + (16 * jt + fr) * HSP + 32 * wave + 16 * et + 4 * fg) = acc2[et][jt];
        __syncthreads();
        {
            const float den = (rsum[j2 * 4] + rsum[j2 * 4 + 1]) + (rsum[j2 * 4 + 2] + rsum[j2 * 4 + 3]) + denq[j2];
            const float inv = 1.f / fmaxf(fabsf(den), 1.f);
            float hv[4][8]; float ss = 0.f;
#pragma unroll
            for (int i = 0; i < 4; ++i) {
                const f32x4 h0 = *(const LAS f32x4*)(Hs + j2 * HSP + 64 * i + 8 * part) * inv, h1 = *(const LAS f32x4*)(Hs + j2 * HSP + 64 * i + 8 * part + 4) * inv;
                hv[i][0] = h0.x; hv[i][1] = h0.y; hv[i][2] = h0.z; hv[i][3] = h0.w; hv[i][4] = h1.x; hv[i][5] = h1.y; hv[i][6] = h1.z; hv[i][7] = h1.w;
#pragma unroll
                for (int u = 0; u < 8; ++u) ss += hv[i][u] * hv[i][u]; }
            ss += shx(ss, 1, lane); ss += shx(ss, 2, lane); ss += shx(ss, 4, lane);
            const float r = rsqrtf(ss * (1.f / 256.f) + EPS);
#pragma unroll
            for (int i = 0; i < 4; ++i) { const int e = 64 * i + 8 * part;
                const v4u ov = ovp[i];
                const f32x4 g0 = *(const f32x4*)(gh + h * 256 + e), g1 = *(const f32x4*)(gh + h * 256 + e + 4);
                const float gg[8] = {g0.x, g0.y, g0.z, g0.w, g1.x, g1.y, g1.z, g1.w};
                v4u o;
#pragma unroll
                for (int w = 0; w < 4; ++w) { const float x0 = hv[i][2 * w] * r * gg[2 * w], x1 = hv[i][2 * w + 1] * r * gg[2 * w + 1];
                    const float o0 = bflo(ov[w]), o1 = bfhi(ov[w]);
                    o[w] = pk2(x0 * __builtin_amdgcn_rcpf(1.f + fexp(-o0)), x1 * __builtin_amdgcn_rcpf(1.f + fexp(-o1))); }
                *(v4u*)(YA + (t0 + j2) * DM + h * 256 + e) = o; }
        }
        __syncthreads();
    }
}

#define XB_TMO      128
#define XB_XCNT(j)  (256  + 64 * (j))
#define XB_XSUB(j)  (1280 + 64 * (j))
#define XB_XGEN(j)  (2304 + 64 * (j))
#define XB_TOP      3328
#define XB_TOPGEN   3392
#define XCD_BAR_WORDS 3456
#define XB_SPIN_CAP (1u << 18)

__device__ __forceinline__ unsigned xb_ld(unsigned* p)              { return __hip_atomic_load(p, __ATOMIC_RELAXED, __HIP_MEMORY_SCOPE_AGENT); }
__device__ __forceinline__ unsigned xb_add(unsigned* p, unsigned v) { return __hip_atomic_fetch_add(p, v, __ATOMIC_RELAXED, __HIP_MEMORY_SCOPE_AGENT); }
__device__ __forceinline__ unsigned xb_xcc_id() { return (unsigned)__builtin_amdgcn_s_getreg((3 << 11) | 20) & 0xFu; }
#define XB_SPIN(cond, bar) do { unsigned _sp = 0; while (cond) { __builtin_amdgcn_s_sleep(1); \
    if ((++_sp & 255u) == 0u) { if (xb_ld(&(bar)[XB_TMO])) break; if (_sp > XB_SPIN_CAP) { atomicAdd(&(bar)[XB_TMO], 1u); break; } } } } while (0)

struct XcdBarrier {
    unsigned* bar; unsigned x;
    volatile LAS unsigned* st;
};

__device__ __forceinline__ XcdBarrier xcd_barrier_post(unsigned* bar, volatile LAS unsigned* st) {
    XcdBarrier b; b.bar = bar; b.x = xb_xcc_id(); b.st = st;
    if (threadIdx.x == 0) (void)xb_add(&bar[XB_XCNT(b.x)], 1u);
    return b;
}
__device__ __forceinline__ void xcd_barrier_complete(unsigned* bar, unsigned x, unsigned& nloc, unsigned& nx) {
    const unsigned G = gridDim.x * gridDim.y * gridDim.z;
    unsigned sum, cnt, mine, sp = 0u;
    for (;;) {
        sum = 0u; cnt = 0u; mine = 0u;
#pragma unroll
        for (unsigned j = 0; j < 16; ++j) { const unsigned c = xb_ld(&bar[XB_XCNT(j)]); sum += c; cnt += (c > 0u) ? 1u : 0u; mine = (j == x) ? c : mine; }
        if (sum == G) break;
        __builtin_amdgcn_s_sleep(1);
        if ((++sp & 255u) == 0u) { if (xb_ld(&bar[XB_TMO])) break; if (sp > XB_SPIN_CAP) { atomicAdd(&bar[XB_TMO], 1u); break; } }
    }
    nloc = mine > 0u ? mine : 1u; nx = cnt > 0u ? cnt : 1u;
}

__device__ __forceinline__ void xcd_barrier(const XcdBarrier& b) {
    asm volatile("s_waitcnt vmcnt(0)" ::: "memory");
    __syncthreads();
    if (threadIdx.x == 0) {
        unsigned* bar = b.bar; asm volatile("" : "+s"(bar));
        __builtin_amdgcn_s_waitcnt(0);
        unsigned nloc = b.st[0], nx = b.st[1];
        if (nloc == 0u) { xcd_barrier_complete(bar, b.x, nloc, nx); b.st[0] = nloc; b.st[1] = nx; }
        const unsigned old = xb_add(&bar[XB_XSUB(b.x)], 1u);
        const unsigned gen = old / nloc;
        if (old + 1u == (gen + 1u) * nloc) {
            __builtin_amdgcn_fence(__ATOMIC_RELEASE, "agent");
            asm volatile("s_waitcnt vmcnt(0)" ::: "memory");
            const unsigned og = xb_add(&bar[XB_TOP], 1u);
            const unsigned tg = og / nx;
            if (og + 1u == (tg + 1u) * nx) xb_add(&bar[XB_TOPGEN], 1u);
            else XB_SPIN(xb_ld(&bar[XB_TOPGEN]) == tg, bar);
            __builtin_amdgcn_fence(__ATOMIC_ACQUIRE, "agent");
            xb_add(&bar[XB_XGEN(b.x)], 1u);
            asm volatile("s_waitcnt vmcnt(0)" ::: "memory");
        } else {
            XB_SPIN(xb_ld(&bar[XB_XGEN(b.x)]) == gen, bar);
            __builtin_amdgcn_fence(__ATOMIC_ACQUIRE, "agent");
            asm volatile("s_waitcnt vmcnt(0)" ::: "memory");
        }
    }
    __syncthreads();
}

__global__ void __launch_bounds__(NTHR, 2) mk_fwd(Args a) {
    extern __shared__ __attribute__((aligned(16))) unsigned char lds_raw[];
    LAS unsigned char* lds = (LAS unsigned char*)lds_raw;
    const int ph_lo = __builtin_amdgcn_readfirstlane(a.ph_lo_), ph_hi = __builtin_amdgcn_readfirstlane(a.ph_hi_);
    for (int u = threadIdx.x; u < 16; u += NTHR) ((LAS unsigned*)(lds + LDS_BYTES - 64))[u] = 0u;
    __syncthreads();
    XcdBarrier xbar; xbar.bar = (unsigned*)a.ws + CW_BAR; xbar.x = xb_xcc_id(); xbar.st = (volatile LAS unsigned*)(lds + LDS_BYTES - 64);
    if (ph_hi - ph_lo > 1 && blockIdx.x == 0) { unsigned* bw = (unsigned*)a.ws + CW_BAR; for (int i = threadIdx.x; i < XCD_BAR_WORDS; i += NTHR) __hip_atomic_store(bw + i, 0u, __ATOMIC_RELAXED, __HIP_MEMORY_SCOPE_AGENT); }
    const int nblk = gridDim.x, NGW = nblk * NWAVES, nthr = nblk * NTHR;
    unsigned char* ws = a.ws;
    bf16* XN = (bf16*)(ws + WS_XN); bf16* PROJ = (bf16*)(ws + WS_PROJ); bf16* STb = (bf16*)(ws + WS_ST); bf16* YA = (bf16*)(ws + WS_YA);
    bf16* Qb = (bf16*)(ws + WS_Q); bf16* Kb = (bf16*)(ws + WS_K); bf16* Vb = (bf16*)(ws + WS_V); bf16* Ob = (bf16*)(ws + WS_O); bf16* Hb = (bf16*)(ws + WS_H);
    float* ROPE = (float*)(ws + WS_ROPE); float* Gt = (float*)(ws + WS_G); float* DEC = (float*)(ws + WS_DEC); float* NST = (float*)(ws + WS_NST);
    for (int ph = ph_lo; ph < ph_hi; ++ph) {
        if (ph > ph_lo) { if (ph == ph_lo + 1) { cg::this_grid().sync(); if (threadIdx.x == 0) (void)xb_add(&xbar.bar[XB_XCNT(xbar.x)], 1u); }   else xcd_barrier(xbar); }
        if (ph > 18 && (ph - 19) % 7 == 1) {
            int bxa = blockIdx.x; asm volatile("" : "+s"(bxa));
            const attn_body::AttnTensors AT{(const attn_body::bf16*)Qb, (const attn_body::bf16*)Kb, (const attn_body::bf16*)Vb, (attn_body::bf16*)Ob};
#ifndef NO_ATTN
            const int Lb = (ph - 19) / 7;
            const float* lam = a.b_lam + (size_t)Lb * 256; int tq = threadIdx.x; asm volatile("" : "+v"(tq)); const int ln = tq & 63;
            const float s01 = wave_sum(lam[ln] * lam[64 + ln], ln), s23 = wave_sum(lam[128 + ln] * lam[192 + ln], ln);
            const float lamf = __int_as_float(__builtin_amdgcn_readfirstlane(__float_as_int(fexp(s01) - fexp(s23) + a.lam_init[Lb])));
            const attn_body::Comb CB{(attn_body::bf16*)YA, a.b_g_head + (size_t)Lb * DM, lamf, a.lam_init[Lb]};
            attn_body::attn_phase<8>((char*)lds_raw, AT, CB, nblk, bxa);
#endif
            continue;
        }
        int tid_o = threadIdx.x, bx_o = blockIdx.x; asm volatile("" : "+v"(tid_o)); asm volatile("" : "+s"(bx_o));
        const int tid = tid_o, bx = bx_o, lane = tid & 63, wave = __builtin_amdgcn_readfirstlane(tid >> 6), gw = bx * NWAVES + wave, gtid = bx * NTHR + tid;
        if (ph == 0) {
            conv_weights(a, 0, lds, gw, NGW, wave, lane);
            rope_table(a.pos, ROPE, gtid, nthr);
            __syncthreads();
            NormJob J{a.x, nullptr, nullptr, nullptr, a.norm_g, XN, nullptr, nullptr, a.a_w_in + NPROJ, a.a_b_gates, Gt};
            norm_phase(J, lds, gw, NGW, tid, lane);
            continue;
        }
        int L, sub;
        if (ph <= 18) { L = (ph - 1) / 9; sub = (ph - 1) % 9; } else { const int q = ph - 19, sb = q % 7; L = 2 + q / 7; sub = sb + (sb >= 2 ? 2 : sb); }
        const bool isA = L < 2;
        if (sub == 0 || sub == 4 || sub == 6 || sub == 7) {
            const int ng = (sub == 0 && L == 2) ? 2 : 1;
            for (int gi = 0; gi < ng; ++gi) {
                pg8::Gemm g; pg8::EpiBf16 E; E.act = 0; E.split_cols = 0; E.split_stride = 0; E.scale0 = 1.f; E.rope = nullptr; E.rope_cols = 0;
                if (sub == 0) {
                    if (isA) { g = pg8::Gemm{XN, (const bf16*)(ws + WS_WA), TT, NPROJ, DM}; E.O = PROJ; E.ldc = NPROJ; }
                    else if (gi == 0) { g = pg8::Gemm{XN, (const bf16*)(ws + WS_WA), TT, DM, DM}; E.O = Qb; E.ldc = DM; E.split_cols = DM; E.scale0 = attn_body::C2; E.rope = ROPE; E.rope_cols = DM; }
                    else { g = pg8::Gemm{YA, (const bf16*)(ws + WS_WA) + (size_t)DM * DM, TT, 2 * DM, DM}; E.O = Kb; E.ldc = DM; E.split_cols = DM; E.split_stride = (WS_V - WS_K) / 2; E.rope = ROPE; E.rope_cols = DM; }
                } else if (sub == 4) { g = pg8::Gemm{YA, (const bf16*)(ws + WS_WO), TT, DM, DM}; E.O = XN; E.ldc = DM; }
                else if (sub == 6) { g = pg8::Gemm{XN, (const bf16*)(ws + WS_WU), TT, FF, DM}; E.O = Hb; E.ldc = FF; E.act = 2; }
                else { g = pg8::Gemm{Hb, (const bf16*)(ws + WS_WD), TT, DM, FF}; E.O = XN; E.ldc = DM; }
                pg8::StaticOrder S; S.init(g.M, g.N, nblk, bx);
#ifndef NO_GEMM
                for (int rp = 0; rp < PROBE_GEMM; ++rp) pg8::gemm_phase<pg8::EpiBf16, pg8::StaticOrder, true, true>(lds, g, S, E);
#endif
            }
        } else if (sub == 5 || sub == 8) {
            NormJob J{(L == 0 && sub == 5) ? a.x : a.out, a.out, XN, a.norm_g + (size_t)(L * 4 + (sub == 5 ? 1 : 3)) * DM, nullptr, XN, nullptr, nullptr, nullptr, nullptr, Gt};
            if (sub == 5) J.gpre = a.norm_g + (size_t)(L * 4 + 2) * DM;
            else if (L < 3) {
                conv_weights(a, L + 1, lds, gw, NGW, wave, lane);
                __syncthreads();
                J.gpre = a.norm_g + (size_t)((L + 1) * 4) * DM;
                if (L + 1 < 2) { J.wg = a.a_w_in + (size_t)(L + 1) * DM * MPROJ + NPROJ; J.bg = a.a_b_gates + (L + 1) * 8; }
                if (L + 1 == 2) { J.gkv = a.kv_norm_g; J.XKV = YA; }
            }
            norm_phase(J, lds, gw, NGW, tid, lane);
        } else if (isA) {
#ifndef NO_M
            if (sub == 1) for (int rp = 0; rp < PROBE_M; ++rp) m1_phase(lds, PROJ, Gt, STb, DEC, NST, nblk, bx, tid, lane, wave);
            else if (sub == 2) m2_phase(STb, DEC, NST, gtid, nthr);
            else for (int rp = 0; rp < PROBE_M; ++rp) m3_phase(lds, PROJ, Gt, STb, NST, a.a_g_head + (size_t)L * DM, YA, nblk, bx, tid, lane, wave);
#endif
        } else {
        }
    }
}

extern "C" void kernel_launch(void* const* d_in, const int* in_sizes, int n_in, void* d_out, int out_size, void* d_ws, size_t ws_size, hipStream_t stream) {
    static int grid = 0;
    if (grid == 0) {
        if (n_in != 15 || in_sizes[0] != TT * DM || out_size != TT * DM || ws_size < WS_END) { fprintf(stderr, "kernel_launch: unexpected shapes / workspace (n_in %d, in0 %d, out %d, ws %zu); nothing launched\n", n_in, n_in > 0 ? in_sizes[0] : -1, out_size, ws_size); grid = -1; return; }
        int dev = 0, cus = 0, per_cu = 0;
        if (hipGetDevice(&dev) != hipSuccess || hipDeviceGetAttribute(&cus, hipDeviceAttributeMultiprocessorCount, dev) != hipSuccess) { grid = -1; return; }
        if (hipFuncSetAttribute((const void*)mk_fwd, hipFuncAttributeMaxDynamicSharedMemorySize, LDS_BYTES) != hipSuccess) { fprintf(stderr, "kernel_launch: hipFuncSetAttribute failed\n"); grid = -1; return; }
        if (hipOccupancyMaxActiveBlocksPerMultiprocessor(&per_cu, (const void*)mk_fwd, NTHR, LDS_BYTES) != hipSuccess || per_cu < 1) per_cu = 1;
        (void)hipGetLastError();
        grid = cus * per_cu;
    }
    if (grid < 0) return;
    Args a{};
    a.x = (const float*)d_in[0]; a.pos = (const int*)d_in[1]; a.norm_g = (const float*)d_in[2]; a.a_w_in = (const float*)d_in[3]; a.a_b_gates = (const float*)d_in[4];
    a.a_g_head = (const float*)d_in[5]; a.a_w_out = (const float*)d_in[6]; a.kv_norm_g = (const float*)d_in[7]; a.w_kv = (const float*)d_in[8]; a.b_w_q = (const float*)d_in[9];
    a.b_lam = (const float*)d_in[10]; a.b_g_head = (const float*)d_in[11]; a.b_w_out = (const float*)d_in[12]; a.mlp_up = (const float*)d_in[13]; a.mlp_down = (const float*)d_in[14];
    a.out = (float*)d_out; a.ws = (unsigned char*)d_ws;
    a.lam_init[0] = (float)(0.8 - 0.6 * exp(-0.3 * 2.0)); a.lam_init[1] = (float)(0.8 - 0.6 * exp(-0.3 * 3.0));
#if MK_MULTI
    for (int ph = 0; ph < NPH; ++ph) { a.ph_lo_ = ph; a.ph_hi_ = ph + 1; hipLaunchKernelGGL(mk_fwd, dim3(grid), dim3(NTHR), LDS_BYTES, stream, a); }
#else
    a.ph_lo_ = 0; a.ph_hi_ = NPH;
    void* args[] = {&a};
    hipError_t e = hipLaunchCooperativeKernel((const void*)mk_fwd, dim3(grid), dim3(NTHR), args, LDS_BYTES, stream);
    if (e != hipSuccess) fprintf(stderr, "cooperative launch failed: %s (grid %d)\n", hipGetErrorString(e), grid);
#endif
}
```
